# Optimizing an MI355X kernel written in HIP

```python
import math
import jax, jax.numpy as jnp
from jax import lax
import numpy as np

D_MODEL = 2048
BATCH = 2
SEQ = 8192
DEPTH = 4

HEAD_DIM = 128
MIX_WIDTH = 2048
Q_BLOCK = 128
ROPE_THETA = 10000.0
EPS = 1e-6
MASKED = -1e30
FORCED = 1e9
NSA_HEADS = 8
NSA_KV_GROUPS = 2
NSA_CMP_LEN = 32
NSA_CMP_STRIDE = 16
NSA_CMP_HIDDEN = 256
NSA_SEL_LEN = 64
NSA_SEL_TOPN = 16
NSA_WINDOW = 512
DIFF_HEADS = 4
DIFF_QK_DIM = 64
DIFF_V_DIM = 128
DSA_HEADS = 12
DSA_KV_HEADS = 4
IDX_HEADS = 16
IDX_DIM = 64
DSA_TOPK_MAX = 256
MEM_HEADS = 4
MEM_LEN = 256

EVEN_SPLITS = (
    NSA_HEADS * HEAD_DIM,
    6 * NSA_KV_GROUPS * HEAD_DIM,
    NSA_HEADS * 3,
    NSA_HEADS * HEAD_DIM,
    DIFF_HEADS * 2 * DIFF_QK_DIM,
    DIFF_HEADS * 2 * DIFF_QK_DIM,
    DIFF_HEADS * DIFF_V_DIM,
    DIFF_HEADS * DIFF_V_DIM,
    MEM_HEADS * HEAD_DIM,
    MEM_HEADS * HEAD_DIM,
)
ODD_SPLITS = (
    DSA_HEADS * HEAD_DIM,
    DSA_KV_HEADS * HEAD_DIM,
    DSA_KV_HEADS * HEAD_DIM,
    IDX_HEADS * IDX_DIM,
    IDX_DIM,
    IDX_HEADS,
    DSA_HEADS * HEAD_DIM,
    MEM_HEADS * HEAD_DIM,
    MEM_HEADS * HEAD_DIM,
)
EVEN_IN = sum(EVEN_SPLITS)
ODD_IN = sum(ODD_SPLITS)

kernel_name = "hybrid_nsa_diff_dsa_memory_trunk"


def rms_norm(x, gain):
    xf = x.astype(jnp.float32)
    y = xf * lax.rsqrt(jnp.mean(xf * xf, axis=-1, keepdims=True) + EPS)
    return (y * gain.astype(jnp.float32)).astype(x.dtype)


def rope(x, pos):
    half = x.shape[-1] // 2
    inv = ROPE_THETA ** (-jnp.arange(half, dtype=jnp.float32) / half)
    ang = pos.astype(jnp.float32)[:, None] * inv[None, :]
    cos = jnp.cos(ang)[:, None, :]
    sin = jnp.sin(ang)[:, None, :]
    xf = x.astype(jnp.float32)
    x1, x2 = xf[..., :half], xf[..., half:]
    return jnp.concatenate([x1 * cos - x2 * sin, x2 * cos + x1 * sin], axis=-1).astype(x.dtype)


def masked_softmax(scores, mask):
    s = jnp.where(mask, scores.astype(jnp.float32), MASKED)
    m = jnp.max(s, axis=-1, keepdims=True)
    e = jnp.exp(s - m) * mask
    return e / jnp.maximum(jnp.sum(e, axis=-1, keepdims=True), 1e-30)


def split_cols(h, sizes):
    return jnp.split(h, np.cumsum(sizes)[:-1].tolist(), axis=-1)


def unblock(y):
    y = jnp.moveaxis(y, 0, 1)
    return y.reshape((y.shape[0], y.shape[1] * y.shape[2]) + y.shape[3:])


def nsa_attention(q, kv, gate_logits, pos, cmp_pos, cmp_w1, cmp_w2, qk_gain):
    B, S, H, Dh = q.shape
    G = NSA_KV_GROUPS
    R = H // G
    scale = Dh ** -0.5
    n_cmp = (S - NSA_CMP_LEN) // NSA_CMP_STRIDE + 1
    n_sel = S // NSA_SEL_LEN
    top_n = min(NSA_SEL_TOPN, n_sel)
    cmp_start = np.arange(n_cmp) * NSA_CMP_STRIDE
    cmp_last = jnp.asarray(cmp_start + NSA_CMP_LEN - 1, dtype=jnp.int32)
    cmp_gather = cmp_start[:, None] + np.arange(NSA_CMP_LEN)[None, :]
    sel_start = np.arange(n_sel) * NSA_SEL_LEN
    ov = np.clip(np.minimum(cmp_start[:, None] + NSA_CMP_LEN, sel_start[None, :] + NSA_SEL_LEN)
                 - np.maximum(cmp_start[:, None], sel_start[None, :]), 0, None) / NSA_CMP_LEN
    overlap = jnp.asarray(ov, dtype=jnp.float32)

    qg = rope(rms_norm(q, qk_gain[0]), pos).reshape(B, S, G, R, Dh)
    k_c_raw, v_c_raw, k_s, v_s, k_w, v_w = [kv[:, :, j] for j in range(6)]

    def compress(t, pe, w1, w2):
        blk = t[:, cmp_gather] + pe[:, None, :]
        blk = blk.transpose(0, 1, 3, 2, 4).reshape(B, n_cmp, G, NSA_CMP_LEN * Dh)
        hid = jax.nn.silu(jnp.einsum('bcgf,fh->bcgh', blk, w1))
        return jnp.einsum('bcgh,hd->bcgd', hid, w2)

    k_c = rope(rms_norm(compress(k_c_raw, cmp_pos[0], cmp_w1[0], cmp_w2[0]), qk_gain[1]), cmp_last)
    v_c = compress(v_c_raw, cmp_pos[1], cmp_w1[1], cmp_w2[1])
    k_s = rope(rms_norm(k_s, qk_gain[2]), pos)
    k_w = rope(rms_norm(k_w, qk_gain[3]), pos)

    def to_blocks(t):
        return t.reshape(B, n_sel, NSA_SEL_LEN, G, Dh).transpose(0, 3, 1, 2, 4)

    k_s_blk, v_s_blk = to_blocks(k_s), to_blocks(v_s)
    pad = ((0, 0), (NSA_WINDOW, 0), (0, 0), (0, 0))
    k_w_pad, v_w_pad = jnp.pad(k_w, pad), jnp.pad(v_w, pad)
    gather_blocks = jax.vmap(jax.vmap(lambda tb, ii: tb[ii]))
    sel_ids = jnp.arange(n_sel)
    sel_off = jnp.arange(NSA_SEL_LEN)
    win_off = jnp.arange(NSA_WINDOW + Q_BLOCK)
    vdt = v_c.dtype

    def block(bi):
        q0 = bi * Q_BLOCK
        t = q0 + jnp.arange(Q_BLOCK)
        qb = lax.dynamic_slice_in_dim(qg, q0, Q_BLOCK, 1)
        p_c = masked_softmax(jnp.einsum('btgrd,bcgd->bgrtc', qb, k_c) * scale,
                             cmp_last[None, :] <= t[:, None])
        o_c = jnp.einsum('bgrtc,bcgd->btgrd', p_c.astype(vdt), v_c)
        imp = jnp.einsum('bgrtc,cj->bgtj', p_c, overlap)
        cur = t // NSA_SEL_LEN
        visible = sel_ids[None, :] <= cur[:, None]
        forced = (sel_ids[None, :] == 0) | (sel_ids[None, :] >= cur[:, None] - 1)
        imp = jnp.where(visible, jnp.where(forced, FORCED, imp), MASKED)
        _, idx = lax.top_k(imp, top_n)
        k_sel = gather_blocks(k_s_blk, idx).reshape(B, G, Q_BLOCK, top_n * NSA_SEL_LEN, Dh)
        v_sel = gather_blocks(v_s_blk, idx).reshape(B, G, Q_BLOCK, top_n * NSA_SEL_LEN, Dh)
        tok = (idx[..., None] * NSA_SEL_LEN + sel_off).reshape(B, G, Q_BLOCK, top_n * NSA_SEL_LEN)
        mask_s = (tok <= t[None, None, :, None])[:, :, None]
        p_s = masked_softmax(jnp.einsum('btgrd,bgtkd->bgrtk', qb, k_sel) * scale, mask_s)
        o_s = jnp.einsum('bgrtk,bgtkd->btgrd', p_s.astype(vdt), v_sel)
        kw = lax.dynamic_slice_in_dim(k_w_pad, q0, NSA_WINDOW + Q_BLOCK, 1)
        vw = lax.dynamic_slice_in_dim(v_w_pad, q0, NSA_WINDOW + Q_BLOCK, 1)
        s_pos = q0 - NSA_WINDOW + win_off
        mask_w = ((s_pos[None, :] <= t[:, None]) & (s_pos[None, :] > t[:, None] - NSA_WINDOW)
                  & (s_pos[None, :] >= 0))
        p_w = masked_softmax(jnp.einsum('btgrd,bkgd->bgrtk', qb, kw) * scale, mask_w)
        o_w = jnp.einsum('bgrtk,bkgd->btgrd', p_w.astype(vdt), vw)
        g = jax.nn.sigmoid(lax.dynamic_slice_in_dim(gate_logits, q0, Q_BLOCK, 1).astype(jnp.float32))
        g = g.astype(vdt).reshape(B, Q_BLOCK, G, R, 3)
        return g[..., 0:1] * o_c + g[..., 1:2] * o_s + g[..., 2:3] * o_w

    out = unblock(lax.map(block, jnp.arange(S // Q_BLOCK)))
    return out.reshape(B, S, H * Dh)


def diff_attention(q, k, v, pos, qk_gain, lam_vecs, subln_gain, lambda_init):
    B, S, H, _, dq = q.shape
    q = rope(rms_norm(q, qk_gain[0]).reshape(B, S, 2 * H, dq), pos).reshape(B, S, H, 2, dq)
    k = rope(rms_norm(k, qk_gain[1]).reshape(B, S, 2 * H, dq), pos).reshape(B, S, H, 2, dq)
    lv = lam_vecs.astype(jnp.float32)
    lam = jnp.exp(jnp.sum(lv[0] * lv[1])) - jnp.exp(jnp.sum(lv[2] * lv[3])) + lambda_init
    key_pos = jnp.arange(S)

    def block(bi):
        q0 = bi * Q_BLOCK
        t = q0 + jnp.arange(Q_BLOCK)
        qb = lax.dynamic_slice_in_dim(q, q0, Q_BLOCK, 1)
        p = masked_softmax(jnp.einsum('bthcd,bshcd->bhcts', qb, k) * dq ** -0.5,
                           key_pos[None, :] <= t[:, None])
        a = p[:, :, 0] - lam * p[:, :, 1]
        return jnp.einsum('bhts,bshd->bthd', a.astype(v.dtype), v)

    o = unblock(lax.map(block, jnp.arange(S // Q_BLOCK)))
    o = rms_norm(o, subln_gain) * (1.0 - lambda_init)
    return o.reshape(B, S, H * v.shape[-1])


def dsa_attention(q, k, v, q_idx, k_idx, w_idx, pos, qk_gain):
    B, S, H, Dh = q.shape
    G = DSA_KV_HEADS
    R = H // G
    top_k = min(DSA_TOPK_MAX, S // 4)
    scale = Dh ** -0.5
    qg = rope(rms_norm(q, qk_gain[0]), pos).reshape(B, S, G, R, Dh)
    k = rope(rms_norm(k, qk_gain[1]), pos)
    q_idx = rope(q_idx, pos)
    k_idx = rope(k_idx[:, :, None, :], pos)[:, :, 0]
    w_idx = w_idx * (IDX_HEADS ** -0.5 * IDX_DIM ** -0.5)
    key_pos = jnp.arange(S)
    gather = jax.vmap(lambda tt, ii: tt[ii])

    def block(bi):
        q0 = bi * Q_BLOCK
        t = q0 + jnp.arange(Q_BLOCK)
        qb = lax.dynamic_slice_in_dim(qg, q0, Q_BLOCK, 1)
        qi = lax.dynamic_slice_in_dim(q_idx, q0, Q_BLOCK, 1)
        wi = lax.dynamic_slice_in_dim(w_idx, q0, Q_BLOCK, 1)
        rel = jax.nn.relu(jnp.einsum('bthd,bsd->bths', qi, k_idx)).astype(jnp.float32)
        score = jnp.einsum('bths,bth->bts', rel, wi.astype(jnp.float32))
        causal = key_pos[None, :] <= t[:, None]
        _, idx = lax.top_k(jnp.where(causal, score, MASKED), top_k)
        kg = gather(k, idx)
        vg = gather(v, idx)
        ok = (idx <= t[None, :, None])[:, None, None]
        p = masked_softmax(jnp.einsum('btgrd,btkgd->bgrtk', qb, kg) * scale, ok)
        return jnp.einsum('bgrtk,btkgd->btgrd', p.astype(v.dtype), vg)

    out = unblock(lax.map(block, jnp.arange(S // Q_BLOCK)))
    return out.reshape(B, S, H * Dh)


def memory_attention(q, mem_n, w_kv, qk_gain):
    B, S, H, Dh = q.shape
    kv = jnp.einsum('bmd,dc->bmc', mem_n, w_kv).reshape(B, mem_n.shape[1], 2, H, Dh)
    k = rms_norm(kv[:, :, 0], qk_gain[1])
    v = kv[:, :, 1]
    q = rms_norm(q, qk_gain[0])
    p = jax.nn.softmax((jnp.einsum('bshd,bmhd->bhsm', q, k) * Dh ** -0.5).astype(jnp.float32), axis=-1)
    return jnp.einsum('bhsm,bmhd->bshd', p.astype(v.dtype), v).reshape(B, S, H * Dh)


def setup_inputs(seed: int = 0) -> dict:
    key = jax.random.key(seed)
    ks = jax.random.split(key, 17)
    n_even = (DEPTH + 1) // 2
    n_odd = DEPTH // 2

    def nrm(k, shape, scale):
        return jax.random.normal(k, shape, jnp.float32) * scale

    def gain(k, shape):
        return 1.0 + 0.02 * jax.random.normal(k, shape, jnp.float32)

    return {
        "x": nrm(ks[0], (BATCH, SEQ, D_MODEL), 1.0),
        "mem": nrm(ks[1], (BATCH, MEM_LEN, D_MODEL), 1.0),
        "norm_gain": gain(ks[2], (DEPTH, D_MODEL)),
        "mem_norm_gain": gain(ks[3], (D_MODEL,)),
        "mem_w_kv": nrm(ks[4], (DEPTH, D_MODEL, 2 * MEM_HEADS * HEAD_DIM), D_MODEL ** -0.5),
        "mem_qk_gain": gain(ks[5], (DEPTH, 2, HEAD_DIM)),
        "w_out": nrm(ks[6], (DEPTH, MIX_WIDTH, D_MODEL), MIX_WIDTH ** -0.5),
        "even_w_in": nrm(ks[7], (n_even, D_MODEL, EVEN_IN), D_MODEL ** -0.5),
        "nsa_qk_gain": gain(ks[8], (n_even, 4, HEAD_DIM)),
        "nsa_cmp_pos": nrm(ks[9], (n_even, 2, NSA_CMP_LEN, HEAD_DIM), 0.3),
        "nsa_cmp_w1": nrm(ks[10], (n_even, 2, NSA_CMP_LEN * HEAD_DIM, NSA_CMP_HIDDEN), (NSA_CMP_LEN * HEAD_DIM) ** -0.5),
        "nsa_cmp_w2": nrm(ks[11], (n_even, 2, NSA_CMP_HIDDEN, HEAD_DIM), NSA_CMP_HIDDEN ** -0.5),
        "diff_qk_gain": gain(ks[12], (n_even, 2, DIFF_QK_DIM)),
        "diff_lambda": nrm(ks[13], (n_even, 4, DIFF_QK_DIM), 0.1),
        "diff_subln_gain": gain(ks[14], (n_even, DIFF_V_DIM)),
        "odd_w_in": nrm(ks[15], (n_odd, D_MODEL, ODD_IN), D_MODEL ** -0.5),
        "dsa_qk_gain": gain(ks[16], (n_odd, 2, HEAD_DIM)),
    }


def reference(x, mem, norm_gain, mem_norm_gain, mem_w_kv, mem_qk_gain, w_out, even_w_in,
              nsa_qk_gain, nsa_cmp_pos, nsa_cmp_w1, nsa_cmp_w2, diff_qk_gain, diff_lambda,
              diff_subln_gain, odd_w_in, dsa_qk_gain):
    B, S, _ = x.shape
    pos = jnp.arange(S)
    mem_n = rms_norm(mem, mem_norm_gain)
    for i in range(DEPTH):
        h = rms_norm(x, norm_gain[i])
        if i % 2 == 0:
            e = i // 2
            proj = jnp.einsum('bsd,dc->bsc', h, even_w_in[e])
            a_q, a_kv, a_g, a_z, b_q, b_k, b_v, b_z, m_q, m_z = split_cols(proj, EVEN_SPLITS)
            y_a = nsa_attention(a_q.reshape(B, S, NSA_HEADS, HEAD_DIM),
                                a_kv.reshape(B, S, 6, NSA_KV_GROUPS, HEAD_DIM),
                                a_g.reshape(B, S, NSA_HEADS, 3), pos,
                                nsa_cmp_pos[e], nsa_cmp_w1[e], nsa_cmp_w2[e], nsa_qk_gain[e])
            lambda_init = 0.8 - 0.6 * math.exp(-0.3 * i)
            y_b = diff_attention(b_q.reshape(B, S, DIFF_HEADS, 2, DIFF_QK_DIM),
                                 b_k.reshape(B, S, DIFF_HEADS, 2, DIFF_QK_DIM),
                                 b_v.reshape(B, S, DIFF_HEADS, DIFF_V_DIM), pos,
                                 diff_qk_gain[e], diff_lambda[e], diff_subln_gain[e], lambda_init)
            y_m = memory_attention(m_q.reshape(B, S, MEM_HEADS, HEAD_DIM), mem_n, mem_w_kv[i], mem_qk_gain[i])
            y = jnp.concatenate([y_a * jax.nn.silu(a_z), y_b * jax.nn.silu(b_z),
                                 y_m * jax.nn.silu(m_z)], axis=-1)
        else:
            o = i // 2
            proj = jnp.einsum('bsd,dc->bsc', h, odd_w_in[o])
            c_q, c_k, c_v, i_q, i_k, i_w, c_z, m_q, m_z = split_cols(proj, ODD_SPLITS)
            y_c = dsa_attention(c_q.reshape(B, S, DSA_HEADS, HEAD_DIM),
                                c_k.reshape(B, S, DSA_KV_HEADS, HEAD_DIM),
                                c_v.reshape(B, S, DSA_KV_HEADS, HEAD_DIM),
                                i_q.reshape(B, S, IDX_HEADS, IDX_DIM), i_k, i_w, pos, dsa_qk_gain[o])
            y_m = memory_attention(m_q.reshape(B, S, MEM_HEADS, HEAD_DIM), mem_n, mem_w_kv[i], mem_qk_gain[i])
            y = jnp.concatenate([y_c * jax.nn.silu(c_z), y_m * jax.nn.silu(m_z)], axis=-1)
        x = x + jnp.einsum('bsc,cd->bsd', y, w_out[i])
    return x
```

```cpp
#include <hip/hip_runtime.h>
#include <hip/hip_cooperative_groups.h>
#include <stdint.h>
#include <stdio.h>
#include <string.h>
namespace cg = cooperative_groups;

#define DI __device__ __forceinline__
typedef unsigned short u16;
typedef unsigned int u32;
typedef unsigned long long u64;
typedef __attribute__((ext_vector_type(8))) short bf16x8;
typedef __attribute__((ext_vector_type(16))) float f32x16;
typedef __attribute__((ext_vector_type(2))) float f32x2;
typedef __attribute__((ext_vector_type(4))) float f32x4;
typedef __attribute__((ext_vector_type(4))) unsigned int u32x4;
typedef __attribute__((ext_vector_type(2))) unsigned int u32x2;
typedef __attribute__((ext_vector_type(2))) __bf16 bf16x2;
#define MFMA32(a, b, c) __builtin_amdgcn_mfma_f32_32x32x16_bf16((a), (b), (c), 0, 0, 0)

constexpr int NB = 2, SEQ = 8192, DM = 2048, NTOK = NB * SEQ;
constexpr int EVEN_IN = 6680, ODD_IN = 6224, EVEN_NT = 53, ODD_NT = 49;
constexpr float EPS = 1e-6f;
constexpr float LOG2E = 1.4426950408889634f;
constexpr int NTHREADS = 256;

constexpr size_t MiB = 1ull << 20;
constexpr size_t OFF_CTR = 0;
constexpr size_t OFF_MISC = 4096;
constexpr size_t OFF_COS64 = 8192;
constexpr size_t OFF_SIN64 = OFF_COS64 + 2 * MiB;
constexpr size_t OFF_COS32 = OFF_SIN64 + 2 * MiB;
constexpr size_t OFF_SIN32 = OFF_COS32 + 1 * MiB;
constexpr size_t OFF_MEMN = OFF_SIN32 + 1 * MiB;
constexpr size_t OFF_MEMK = OFF_MEMN + 2 * MiB;
constexpr size_t OFF_MEMVT = OFF_MEMK + 2 * MiB;
constexpr size_t OFF_WKVT = OFF_MEMVT + 2 * MiB;
constexpr size_t OFF_WTIN = OFF_WKVT + 16 * MiB;
constexpr size_t OFF_WTOUT = OFF_WTIN + 27 * MiB;
constexpr size_t OFF_W1T = OFF_WTOUT + 8 * MiB;
constexpr size_t OFF_W2T = OFF_W1T + 4 * MiB;
constexpr size_t OFF_CBIAS = OFF_W2T + 128 * 1024;
constexpr size_t OFF_CBPART = OFF_CBIAS + 4096;
constexpr size_t OFF_BAR = OFF_CBPART + 131072;
constexpr size_t OFF_HY = OFF_CBIAS + 4096 + 8192 + (MiB - 128 * 1024 - 4096 - 8192 - 8192);
constexpr size_t OFF_Z = OFF_HY + 64 * MiB;
constexpr size_t OFF_L = OFF_Z + 64 * MiB;
constexpr size_t E_QA = OFF_L;
constexpr size_t E_KCRAW = E_QA + 32 * MiB;
constexpr size_t E_VCRAW = E_KCRAW + 8 * MiB;
constexpr size_t E_KS = E_VCRAW + 8 * MiB;
constexpr size_t E_VST = E_KS + 8 * MiB;
constexpr size_t E_KW = E_VST + 8 * MiB;
constexpr size_t E_VWT = E_KW + 8 * MiB;
constexpr size_t E_AG = E_VWT + 8 * MiB;
constexpr size_t E_BQ = E_AG + 2 * MiB;
constexpr size_t E_BK = E_BQ + 16 * MiB;
constexpr size_t E_BVT = E_BK + 16 * MiB;
constexpr size_t E_MQ = E_BVT + 16 * MiB;
constexpr size_t E_KC = E_MQ + 16 * MiB;
constexpr size_t E_VCT = E_KC + MiB / 2;
constexpr size_t E_HID = E_VCT + MiB / 2;
constexpr size_t E_SELM = E_HID + 2 * MiB;
constexpr size_t E_END = E_SELM + MiB / 2;
constexpr size_t O_CQ = OFF_L;
constexpr size_t O_CK = O_CQ + 48 * MiB;
constexpr size_t O_CVT = O_CK + 16 * MiB;
constexpr size_t O_IQ = O_CVT + 16 * MiB;
constexpr size_t O_IK = O_IQ + 32 * MiB;
constexpr size_t O_IW = O_IK + 2 * MiB;
constexpr size_t O_MQ = O_IW + 1 * MiB;
constexpr size_t O_DMASK = O_MQ + 16 * MiB;
constexpr size_t O_SC = O_DMASK + 16 * MiB;
constexpr size_t SC_PER_B = 16384ull * (64 * 65 / 2);
constexpr size_t O_END = O_SC + 2 * SC_PER_B * 2;

struct Params {
  const float *x, *mem, *norm_gain, *mem_norm_gain, *mem_w_kv, *mem_qk_gain, *w_out, *even_w_in, *nsa_qk_gain,
      *nsa_cmp_pos, *nsa_cmp_w1, *nsa_cmp_w2, *diff_qk_gain, *diff_lambda, *diff_subln_gain, *odd_w_in, *dsa_qk_gain;
  float* out;
  char* ws;
  int ph_begin, ph_end;
};

DI u16 f2bf(float x) {
  u32 u = __float_as_uint(x);
  u += 0x7fffu + ((u >> 16) & 1u);
  return (u16)(u >> 16);
}
DI u32x4 mku4(u32 a, u32 b, u32 c, u32 d) { u32x4 r = {a, b, c, d}; return r; }
DI u32x2 mku2(u32 a, u32 b) { u32x2 r = {a, b}; return r; }
DI f32x4 mkf4(float a, float b, float c, float d) { f32x4 r = {a, b, c, d}; return r; }
DI float bf2f(u16 v) { return __uint_as_float(((u32)v) << 16); }
DI u32 pk2(float a, float b) {
  f32x2 v = {a, b};
  bf16x2 r = __builtin_convertvector(v, bf16x2);
  return __builtin_bit_cast(u32, r);
}
DI float bflo(u32 v) { return __uint_as_float(v << 16); }
DI float bfhi(u32 v) { return __uint_as_float(v & 0xffff0000u); }
DI float siluf(float v) { return v / (1.f + __expf(-v)); }
DI float sigmf(float v) { return 1.f / (1.f + __expf(-v)); }
DI int otid() {
  int t = __builtin_amdgcn_workitem_id_x();
  asm volatile("" : "+v"(t));
  return t;
}
DI char* ows(char* w) {
  u64 v = (u64)(uintptr_t)w;
  asm volatile("" : "+s"(v));
  return (char*)(__attribute__((address_space(1))) char*)v;
}
DI int crow(int i, int h) { return (i & 3) + 8 * (i >> 2) + 4 * h; }
DI void zero16(f32x16& a) {
#pragma unroll
  for (int i = 0; i < 16; ++i) a[i] = 0.f;
}

DI int next_item(int* ctr, int* s_item) {
  __syncthreads();
  if (otid() == 0) *s_item = atomicAdd(ctr, 1);
  __syncthreads();
  return *s_item;
}

DI void tt_load(f32x4 (&v)[8], const float* __restrict__ src, int lds, int col0, int nvalid, int k0) {
  const int tid = otid();
  const int n4 = (tid & 15) * 4;
#pragma unroll
  for (int i = 0; i < 8; ++i) {
    const int k = (tid >> 4) + 16 * i;
    v[i] = mkf4(0.f, 0.f, 0.f, 0.f);
    if (n4 < nvalid) v[i] = *(const f32x4*)(src + (size_t)(k0 + k) * lds + col0 + n4);
  }
}
DI void tt_store(const f32x4 (&v)[8], u16* __restrict__ dst, int K, int n0, int k0, float* sm) {
  const int tid = otid();
  __syncthreads();
  {
    const int n4 = (tid & 15) * 4;
#pragma unroll
    for (int i = 0; i < 8; ++i) {
      const int k = (tid >> 4) + 16 * i;
      sm[k * 65 + n4 + 0] = v[i].x;
      sm[k * 65 + n4 + 1] = v[i].y;
      sm[k * 65 + n4 + 2] = v[i].z;
      sm[k * 65 + n4 + 3] = v[i].w;
    }
  }
  __syncthreads();
  {
    const int n = tid >> 2, ks = (tid & 3) * 32;
    u32x4* d = (u32x4*)(dst + (size_t)(n0 + n) * K + k0 + ks);
#pragma unroll
    for (int q = 0; q < 4; ++q) {
      u32 o[4];
#pragma unroll
      for (int j = 0; j < 4; ++j)
        o[j] = pk2(sm[(ks + 8 * q + 2 * j) * 65 + n], sm[(ks + 8 * q + 2 * j + 1) * 65 + n]);
      d[q] = mku4(o[0], o[1], o[2], o[3]);
    }
  }
}
DI void transpose_tile(const float* __restrict__ src, int lds, int col0, int nvalid, u16* __restrict__ dst, int K,
                       int n0, int k0, float* sm) {
  f32x4 v[8];
  tt_load(v, src, lds, col0, nvalid, k0);
  tt_store(v, dst, K, n0, k0, sm);
}

DI void rmsnorm_row(const float* __restrict__ src, const float* __restrict__ gain, u16* __restrict__ dst) {
  const int lane = otid() & 63;
  f32x4 v[8];
  float ss = 0.f;
#pragma unroll
  for (int i = 0; i < 8; ++i) {
    v[i] = *(const f32x4*)(src + (i * 64 + lane) * 4);
    ss += v[i].x * v[i].x + v[i].y * v[i].y + v[i].z * v[i].z + v[i].w * v[i].w;
  }
#pragma unroll
  for (int o = 32; o >= 1; o >>= 1) ss += __shfl_xor(ss, o);
  const float rinv = rsqrtf(ss * (1.f / 2048.f) + EPS);
#pragma unroll
  for (int i = 0; i < 8; ++i) {
    const f32x4 g = *(const f32x4*)(gain + (i * 64 + lane) * 4);
    u32x2 o;
    o.x = pk2(v[i].x * rinv * g.x, v[i].y * rinv * g.y);
    o.y = pk2(v[i].z * rinv * g.z, v[i].w * rinv * g.w);
    *(u32x2*)(dst + (i * 64 + lane) * 4) = o;
  }
}

DI void rmsnorm_row2(const float* __restrict__ src0, const float* __restrict__ src1, const float* __restrict__ gain,
                     u16* __restrict__ dst0, u16* __restrict__ dst1) {
  const int lane = otid() & 63;
  f32x4 v[8], u[8];
#pragma unroll
  for (int i = 0; i < 8; ++i) {
    v[i] = *(const f32x4*)(src0 + (i * 64 + lane) * 4);
    u[i] = *(const f32x4*)(src1 + (i * 64 + lane) * 4);
  }
  float ss = 0.f, st = 0.f;
#pragma unroll
  for (int i = 0; i < 8; ++i) {
    ss += v[i].x * v[i].x + v[i].y * v[i].y + v[i].z * v[i].z + v[i].w * v[i].w;
    st += u[i].x * u[i].x + u[i].y * u[i].y + u[i].z * u[i].z + u[i].w * u[i].w;
  }
#pragma unroll
  for (int o = 32; o >= 1; o >>= 1) {
    ss += __shfl_xor(ss, o);
    st += __shfl_xor(st, o);
  }
  const float rv = rsqrtf(ss * (1.f / 2048.f) + EPS), ru = rsqrtf(st * (1.f / 2048.f) + EPS);
#pragma unroll
  for (int i = 0; i < 8; ++i) {
    const f32x4 g = *(const f32x4*)(gain + (i * 64 + lane) * 4);
    u32x2 o;
    o.x = pk2(v[i].x * rv * g.x, v[i].y * rv * g.y);
    o.y = pk2(v[i].z * rv * g.z, v[i].w * rv * g.w);
    *(u32x2*)(dst0 + (i * 64 + lane) * 4) = o;
    o.x = pk2(u[i].x * ru * g.x, u[i].y * ru * g.y);
    o.y = pk2(u[i].z * ru * g.z, u[i].w * ru * g.w);
    *(u32x2*)(dst1 + (i * 64 + lane) * 4) = o;
  }
}
DI int even_src(int nt, int& valid) {
  valid = (nt == 20) ? 24 : 128;
  return nt <= 20 ? 128 * nt : 2584 + 128 * (nt - 21);
}
DI int odd_src(int nt, int& valid) {
  valid = (nt == 28) ? 80 : 128;
  return nt <= 28 ? 128 * nt : 3664 + 128 * (nt - 29);
}

DI void phase_prep(const Params& p, int layer, char* smem) {
  const int tid = otid(), G = gridDim.x, bid = blockIdx.x;
  const int par = layer & 1, e = layer >> 1;
  char* ws = ows(p.ws);
  float* sm = (float*)smem;
  const int gw = bid * 4 + (tid >> 6), nw = G * 4;
  {
    const float* xin = layer == 0 ? p.x : p.out;
    u16* hy = (u16*)(ws + OFF_HY);
    for (int row = gw; row < NTOK; row += 2 * nw) {
      const int row1 = row + nw;
      if (row1 < NTOK)
        rmsnorm_row2(xin + (size_t)row * DM, xin + (size_t)row1 * DM, p.norm_gain + layer * DM, hy + (size_t)row * DM,
                     hy + (size_t)row1 * DM);
      else
        rmsnorm_row(xin + (size_t)row * DM, p.norm_gain + layer * DM, hy + (size_t)row * DM);
    }
  }
  {
    u16* wtin = (u16*)(ws + OFF_WTIN);
    const int ntl = par ? ODD_NT : EVEN_NT;
    const float* win = par ? p.odd_w_in + (size_t)e * DM * ODD_IN : p.even_w_in + (size_t)e * DM * EVEN_IN;
    const int ldw = par ? ODD_IN : EVEN_IN;
    const int ntiles = ntl * 2 * 16;
    auto issue = [&](int it, f32x4(&vv)[8]) __attribute__((always_inline)) {
      const int kt = it & 15, n64 = it >> 4;
      int valid;
      const int sb = par ? odd_src(n64 >> 1, valid) : even_src(n64 >> 1, valid);
      const int half = n64 & 1;
      int nv = valid - 64 * half;
      nv = nv < 0 ? 0 : (nv > 64 ? 64 : nv);
      tt_load(vv, win, ldw, sb + 64 * half, nv, kt * 128);
    };
    f32x4 va[8];
    int it = bid;
    if (it < ntiles) issue(it, va);
    while (it < ntiles) {
      const int itn = it + G;
      f32x4 vb[8];
      if (itn < ntiles) issue(itn, vb);
      tt_store(va, wtin, DM, (it >> 4) * 64, (it & 15) * 128, sm);
#pragma unroll
      for (int i = 0; i < 8; ++i) va[i] = vb[i];
      it = itn;
    }
    u16* wtout = (u16*)(ws + OFF_WTOUT);
    const float* wo = p.w_out + (size_t)layer * DM * DM;
    for (int it = bid; it < 32 * 16; it += G)
      transpose_tile(wo, DM, (it >> 4) * 64, 64, wtout, DM, (it >> 4) * 64, (it & 15) * 128, sm);
  }
  if (!par) {
    u16* w1t = (u16*)(ws + OFF_W1T);
    for (int it = bid; it < 2 * 4 * 32; it += G) {
      const int kv = it >> 7, n64 = (it >> 5) & 3, kt = it & 31;
      transpose_tile(p.nsa_cmp_w1 + ((size_t)(e * 2 + kv)) * 4096 * 256, 256, n64 * 64, 64,
                     w1t + (size_t)kv * 256 * 4096, 4096, n64 * 64, kt * 128, sm);
    }
    u16* w2t = (u16*)(ws + OFF_W2T);
    for (int it = bid; it < 2 * 2 * 2; it += G) {
      const int kv = it >> 2, n64 = (it >> 1) & 1, kt = it & 1;
      transpose_tile(p.nsa_cmp_w2 + ((size_t)(e * 2 + kv)) * 256 * 128, 128, n64 * 64, 64, w2t + (size_t)kv * 128 * 256,
                     256, n64 * 64, kt * 128, sm);
    }
    float* cbp = (float*)(ws + OFF_CBPART);
    for (int it = bid; it < 128; it += G) {
      const int kv = it >> 6, chk = it & 63;
      const float* pe = p.nsa_cmp_pos + (size_t)(e * 2 + kv) * 4096 + chk * 64;
      const float* w1 = p.nsa_cmp_w1 + ((size_t)(e * 2 + kv)) * 4096 * 256 + (size_t)chk * 64 * 256;
      float a = 0.f;
#pragma unroll 16
      for (int f = 0; f < 64; ++f) a += pe[f] * w1[(size_t)f * 256 + tid];
      cbp[it * 256 + tid] = a;
    }
    if (bid == G - 1 && tid == 0) {
      const float* lv = p.diff_lambda + (size_t)e * 4 * 64;
      float s0 = 0.f, s1 = 0.f;
      for (int i = 0; i < 64; ++i) {
        s0 += lv[i] * lv[64 + i];
        s1 += lv[128 + i] * lv[192 + i];
      }
      ((float*)(ws + OFF_MISC))[e] = expf(s0) - expf(s1);
    }
  }
}

DI void phase_prep0_extra(const Params& p, char* smem) {
  const int tid = otid(), G = gridDim.x, bid = blockIdx.x;
  char* ws = ows(p.ws);
  float* sm = (float*)smem;
  const int gw = bid * 4 + (tid >> 6), nw = G * 4;
    float* c64 = (float*)(ws + OFF_COS64);
    float* s64 = (float*)(ws + OFF_SIN64);
    float* c32 = (float*)(ws + OFF_COS32);
    float* s32 = (float*)(ws + OFF_SIN32);
    for (int idx = bid * NTHREADS + tid; idx < SEQ * 64; idx += G * NTHREADS) {
      const int t = idx >> 6, i = idx & 63;
      const float inv = powf(10000.f, -(float)i / 64.f);
      const float ang = (float)t * inv;
      c64[idx] = cosf(ang);
      s64[idx] = sinf(ang);
      if (i < 32) {
        const float inv2 = powf(10000.f, -(float)i / 32.f);
        const float a2 = (float)t * inv2;
        c32[t * 32 + i] = cosf(a2);
        s32[t * 32 + i] = sinf(a2);
      }
    }
    u16* memn = (u16*)(ws + OFF_MEMN);
    for (int row = gw; row < NB * 256; row += nw)
      rmsnorm_row(p.mem + (size_t)row * DM, p.mem_norm_gain, memn + (size_t)row * DM);
    u16* wkvt = (u16*)(ws + OFF_WKVT);
    for (int it = bid; it < 4 * 16 * 16; it += G) {
      const int li = it >> 8, n64 = (it >> 4) & 15, kt = it & 15;
      transpose_tile(p.mem_w_kv + (size_t)li * DM * 1024, 1024, n64 * 64, 64, wkvt + (size_t)li * 1024 * DM, DM, n64 * 64,
                     kt * 128, sm);
    }
}

constexpr int GAIN_OFF = (256 + 128) * 72 * 2;
template <bool USTRIDE, class RowF, class EpiF>
DI void gemm_block(const u16* __restrict__ abase, RowF rowoff, int ldk2, const u16* __restrict__ Wt, int K, int m0, int n0,
                   char* smem, EpiF epi, const float* __restrict__ gsrc = nullptr, int gmask = 127) {
  u16* As = (u16*)smem;
  u16* Ws = As + 256 * 72;
  const int tid = otid(), lane = tid & 63, w = tid >> 6, r = lane & 31, h = lane >> 5;
  if (gsrc) {
    __syncthreads();
    if (tid < 128) ((float*)(smem + GAIN_OFF))[tid] = gsrc[tid & gmask];
  }
  f32x16 acc[2][4];
#pragma unroll
  for (int g = 0; g < 2; ++g)
#pragma unroll
    for (int i = 0; i < 4; ++i) zero16(acc[g][i]);
  const int kc = (tid & 7) * 8;
  u32 ao[8];
  if (USTRIDE) {
    ao[0] = rowoff(m0 + (tid >> 3));
    const u32 st32 = rowoff(32) - rowoff(0);
#pragma unroll
    for (int i = 1; i < 8; ++i) ao[i] = ao[0] + st32 * i;
  } else {
#pragma unroll
    for (int i = 0; i < 8; ++i) ao[i] = rowoff(m0 + (tid >> 3) + 32 * i);
  }
  const u16* wp0 = Wt + (size_t)(n0 + (tid >> 3)) * K + kc;
  const size_t wstep = (size_t)32 * K;
  const int lo = (tid >> 3) * 72 + kc;
  u32x4 ra[8], rw[4];
  {
    const int off = (kc >> 7) * ldk2 + (kc & 127);
#pragma unroll
    for (int i = 0; i < 8; ++i) ra[i] = *(const u32x4*)(abase + ao[i] + off);
#pragma unroll
    for (int i = 0; i < 4; ++i) rw[i] = *(const u32x4*)(wp0 + wstep * i);
  }
  for (int k0 = 0; k0 < K; k0 += 64) {
    __syncthreads();
#pragma unroll
    for (int i = 0; i < 8; ++i) *(u32x4*)(As + lo + 32 * 72 * i) = ra[i];
#pragma unroll
    for (int i = 0; i < 4; ++i) *(u32x4*)(Ws + lo + 32 * 72 * i) = rw[i];
    __syncthreads();
    if (k0 + 64 < K) {
      const int k = k0 + 64 + kc;
      const int off = (k >> 7) * ldk2 + (k & 127);
#pragma unroll
      for (int i = 0; i < 8; ++i) ra[i] = *(const u32x4*)(abase + ao[i] + off);
#pragma unroll
      for (int i = 0; i < 4; ++i) rw[i] = *(const u32x4*)(wp0 + wstep * i + k0 + 64);
    }
    __builtin_amdgcn_s_setprio(1);
#pragma unroll
    for (int s = 0; s < 4; ++s) {
      const bf16x8 b0 = *(const bf16x8*)(As + (64 * w + r) * 72 + 16 * s + 8 * h);
      const bf16x8 b1 = *(const bf16x8*)(As + (64 * w + 32 + r) * 72 + 16 * s + 8 * h);
#pragma unroll
      for (int nt = 0; nt < 4; ++nt) {
        const bf16x8 a = *(const bf16x8*)(Ws + (32 * nt + r) * 72 + 16 * s + 8 * h);
        acc[0][nt] = MFMA32(a, b0, acc[0][nt]);
        acc[1][nt] = MFMA32(a, b1, acc[1][nt]);
      }
    }
    __builtin_amdgcn_s_setprio(0);
  }
  __syncthreads();
  const int tok0 = __builtin_amdgcn_readfirstlane(m0 + 64 * w);
  epi(acc[0], tok0 + r, h, tok0);
  epi(acc[1], tok0 + 32 + r, h, tok0 + 32);
}

DI void norm128(f32x16 (&acc)[4], const float* gain, int h) {
  float ss = 0.f;
#pragma unroll
  for (int nt = 0; nt < 4; ++nt)
#pragma unroll
    for (int i = 0; i < 16; ++i) ss += acc[nt][i] * acc[nt][i];
  ss += __shfl_xor(ss, 32);
  const float rinv = rsqrtf(ss * (1.f / 128.f) + EPS);
#pragma unroll
  for (int nt = 0; nt < 4; ++nt) {
#pragma unroll
    for (int ig = 0; ig < 4; ++ig) {
      const f32x4 g = *(const f32x4*)(gain + 32 * nt + 8 * ig + 4 * h);
      acc[nt][4 * ig + 0] *= rinv * g.x;
      acc[nt][4 * ig + 1] *= rinv * g.y;
      acc[nt][4 * ig + 2] *= rinv * g.z;
      acc[nt][4 * ig + 3] *= rinv * g.w;
      if (ig & 1) __builtin_amdgcn_sched_barrier(0);
    }
  }
}
DI void norm64(f32x16 (&acc)[4], const float* gain, int h) {
  float rinv[2];
#pragma unroll
  for (int pp = 0; pp < 2; ++pp) {
    float ss = 0.f;
#pragma unroll
    for (int q = 0; q < 2; ++q)
#pragma unroll
      for (int i = 0; i < 16; ++i) ss += acc[2 * pp + q][i] * acc[2 * pp + q][i];
    ss += __shfl_xor(ss, 32);
    rinv[pp] = rsqrtf(ss * (1.f / 64.f) + EPS);
  }
#pragma unroll
  for (int q = 0; q < 2; ++q) {
#pragma unroll
    for (int ig = 0; ig < 4; ++ig) {
      const f32x4 g = *(const f32x4*)(gain + 32 * q + 8 * ig + 4 * h);
#pragma unroll
      for (int pp = 0; pp < 2; ++pp) {
        acc[2 * pp + q][4 * ig + 0] *= rinv[pp] * g.x;
        acc[2 * pp + q][4 * ig + 1] *= rinv[pp] * g.y;
        acc[2 * pp + q][4 * ig + 2] *= rinv[pp] * g.z;
        acc[2 * pp + q][4 * ig + 3] *= rinv[pp] * g.w;
      }
    }
    __builtin_amdgcn_sched_barrier(0);
  }
}
struct RopeTab128 {
  f32x4 c[4], s[4];
};
DI void rope128_load(RopeTab128& tb, int nt, const float* __restrict__ c64, const float* __restrict__ s64, int t, int h) {
#pragma unroll
  for (int ig = 0; ig < 4; ++ig) {
    const int d1 = 32 * nt + 8 * ig + 4 * h;
    tb.c[ig] = *(const f32x4*)(c64 + t * 64 + d1);
    tb.s[ig] = *(const f32x4*)(s64 + t * 64 + d1);
  }
}
DI void rope128_apply(f32x16 (&acc)[4], int nt, const RopeTab128& tb) {
#pragma unroll
  for (int ig = 0; ig < 4; ++ig)
#pragma unroll
    for (int q = 0; q < 4; ++q) {
      const int i = 4 * ig + q;
      const float c = tb.c[ig][q], sn = tb.s[ig][q];
      const float x1 = acc[nt][i], x2 = acc[nt + 2][i];
      acc[nt][i] = x1 * c - x2 * sn;
      acc[nt + 2][i] = x2 * c + x1 * sn;
    }
}
template <bool EARLY = true>
DI void norm_rope128(f32x16 (&acc)[4], const float* gl, const float* __restrict__ c64, const float* __restrict__ s64, int t, int h) {
  if (EARLY) {
    RopeTab128 tb;
    rope128_load(tb, 0, c64, s64, t, h);
    norm128(acc, gl, h);
    rope128_apply(acc, 0, tb);
    __builtin_amdgcn_sched_barrier(0);
    rope128_load(tb, 1, c64, s64, t, h);
    rope128_apply(acc, 1, tb);
  } else {
    norm128(acc, gl, h);
    __builtin_amdgcn_sched_barrier(0);
#pragma unroll
    for (int nt = 0; nt < 2; ++nt)
#pragma unroll
      for (int hb = 0; hb < 2; ++hb) {
        f32x4 c[2], sn[2];
#pragma unroll
        for (int k = 0; k < 2; ++k) {
          const int d1 = 32 * nt + 8 * (2 * hb + k) + 4 * h;
          c[k] = *(const f32x4*)(c64 + t * 64 + d1);
          sn[k] = *(const f32x4*)(s64 + t * 64 + d1);
        }
#pragma unroll
        for (int k = 0; k < 2; ++k)
#pragma unroll
          for (int q = 0; q < 4; ++q) {
            const int i = 4 * (2 * hb + k) + q;
            const float x1 = acc[nt][i], x2 = acc[nt + 2][i];
            acc[nt][i] = x1 * c[k][q] - x2 * sn[k][q];
            acc[nt + 2][i] = x2 * c[k][q] + x1 * sn[k][q];
          }
        __builtin_amdgcn_sched_barrier(0);
      }
  }
}
struct RopeTab64 {
  f32x4 c[4], s[4];
};
DI void rope64_load(RopeTab64& tb, const float* __restrict__ c32, const float* __restrict__ s32, int t, int h) {
#pragma unroll
  for (int ig = 0; ig < 4; ++ig) {
    const int d1 = 8 * ig + 4 * h;
    tb.c[ig] = *(const f32x4*)(c32 + t * 32 + d1);
    tb.s[ig] = *(const f32x4*)(s32 + t * 32 + d1);
  }
}
DI void rope64_apply(f32x16 (&acc)[4], int pp, const RopeTab64& tb) {
#pragma unroll
  for (int ig = 0; ig < 4; ++ig)
#pragma unroll
    for (int q = 0; q < 4; ++q) {
      const int i = 4 * ig + q;
      const float c = tb.c[ig][q], sn = tb.s[ig][q];
      const float x1 = acc[2 * pp][i], x2 = acc[2 * pp + 1][i];
      acc[2 * pp][i] = x1 * c - x2 * sn;
      acc[2 * pp + 1][i] = x2 * c + x1 * sn;
    }
}
DI void store_plain(const f32x16 (&acc)[4], u16* __restrict__ rowbase, int h) {
#pragma unroll
  for (int nt = 0; nt < 4; ++nt)
#pragma unroll
    for (int ig = 0; ig < 4; ++ig) {
      u32x2 o;
      o.x = pk2(acc[nt][4 * ig], acc[nt][4 * ig + 1]);
      o.y = pk2(acc[nt][4 * ig + 2], acc[nt][4 * ig + 3]);
      *(u32x2*)(rowbase + 32 * nt + 8 * ig + 4 * h) = o;
    }
}
constexpr int WB_LD = 136;
DI void store_rows(const f32x16 (&acc)[4], u16* __restrict__ base0, int ld, char* smem, int h) {
  const int tid = otid(), lane = tid & 63, w = tid >> 6, r = lane & 31;
  u16* wb = (u16*)smem + w * (32 * WB_LD);
#pragma unroll
  for (int nt = 0; nt < 4; ++nt)
#pragma unroll
    for (int ig = 0; ig < 4; ++ig) {
      u32x2 o;
      o.x = pk2(acc[nt][4 * ig], acc[nt][4 * ig + 1]);
      o.y = pk2(acc[nt][4 * ig + 2], acc[nt][4 * ig + 3]);
      *(u32x2*)(wb + r * WB_LD + 32 * nt + 8 * ig + 4 * h) = o;
    }
  __builtin_amdgcn_fence(__ATOMIC_SEQ_CST, "workgroup");
  __builtin_amdgcn_wave_barrier();
#pragma unroll
  for (int it = 0; it < 8; ++it) {
    const int row = it * 4 + (lane >> 4), ch = lane & 15;
    const u32x4 v = *(const u32x4*)(wb + row * WB_LD + ch * 8);
    *(u32x4*)(base0 + (size_t)row * ld + ch * 8) = v;
    if (it & 1) __builtin_amdgcn_sched_barrier(0);
  }
  __builtin_amdgcn_fence(__ATOMIC_SEQ_CST, "workgroup");
  __builtin_amdgcn_wave_barrier();
}
DI void store_vt(const f32x16 (&acc)[4], u16* __restrict__ base, size_t ld, int h) {
#pragma unroll
  for (int nt = 0; nt < 4; ++nt)
#pragma unroll
    for (int i = 0; i < 16; ++i) base[(size_t)(32 * nt + crow(i, h)) * ld] = f2bf(acc[nt][i]);
}

struct XcdInfo {
  int xi, nx, lrank, nloc;
};
DI void phase_proj(const Params& p, int layer, char* smem, const XcdInfo xc) {
  const int G = gridDim.x, bid = blockIdx.x;
  const int par = layer & 1, e = layer >> 1;
  char* ws = ows(p.ws);
  const u16* hy = (const u16*)(ws + OFF_HY);
  const u16* wtin = (const u16*)(ws + OFF_WTIN);
  const float* c64 = (const float*)(ws + OFF_COS64);
  const float* s64 = (const float*)(ws + OFF_SIN64);
  const float* c32 = (const float*)(ws + OFF_COS32);
  const float* s32 = (const float*)(ws + OFF_SIN32);
  u16* zb = (u16*)(ws + OFF_Z);
  if (!par && bid == G - 1) {
    const int tid = otid();
    const float* cbp = (const float*)(ws + OFF_CBPART);
    float* cb = (float*)(ws + OFF_CBIAS);
#pragma unroll
    for (int kv = 0; kv < 2; ++kv) {
      float a = 0.f;
#pragma unroll 16
      for (int c = 0; c < 64; ++c) a += cbp[(kv * 64 + c) * 256 + tid];
      cb[kv * 256 + tid] = a;
    }
  }
  const int ntl = par ? ODD_NT : EVEN_NT;
  const int ntiles = ntl * 64;
  const int mcount = (64 - xc.xi + xc.nx - 1) / xc.nx;
  const int nslots = ((mcount + 1) >> 1) * 2 * ntl;
  (void)ntiles;
  for (int it = xc.lrank; it < nslots; it += xc.nloc) {
    const int grp = it / (2 * ntl), rem = it - grp * 2 * ntl;
    const int nt = rem >> 1, ml = 2 * grp + (rem & 1);
    if (ml >= mcount) continue;
    const int mt = xc.xi + ml * xc.nx;
    auto rowp = [&](int m) __attribute__((always_inline)) { return (u32)m * (u32)DM; };
    const float* gsrc = nullptr;
    if (!par) {
      if (nt < 8) gsrc = p.nsa_qk_gain + (e * 4 + 0) * 128;
      else if (nt >= 12 && nt < 14) gsrc = p.nsa_qk_gain + (e * 4 + 2) * 128;
      else if (nt >= 16 && nt < 18) gsrc = p.nsa_qk_gain + (e * 4 + 3) * 128;
      else if (nt >= 29 && nt < 33) gsrc = p.diff_qk_gain + (e * 2 + 0) * 64;
      else if (nt >= 33 && nt < 37) gsrc = p.diff_qk_gain + (e * 2 + 1) * 64;
      else if (nt >= 45 && nt < 49) gsrc = p.mem_qk_gain + (layer * 2 + 0) * 128;
    } else {
      if (nt < 12) gsrc = p.dsa_qk_gain + (e * 2 + 0) * 128;
      else if (nt < 16) gsrc = p.dsa_qk_gain + (e * 2 + 1) * 128;
      else if (nt >= 41 && nt < 45) gsrc = p.mem_qk_gain + (layer * 2 + 0) * 128;
    }
    const float* gl = (const float*)(smem + GAIN_OFF);
    auto epi = [&](f32x16(&acc)[4], int tok, int h, int tok0) __attribute__((always_inline)) {
      const int t = tok & (SEQ - 1), b = tok >> 13;
      char* ws = ows(p.ws);
      u16* zb = (u16*)(ws + OFF_Z);
      if (!par) {
        if (nt < 8) {
          norm_rope128<false>(acc, gl, c64, s64, t, h);
          store_rows(acc, (u16*)(ws + E_QA) + (size_t)tok0 * 1024 + 128 * nt, 1024, smem, h);
        } else if (nt < 20) {
          const int j = (nt - 8) >> 1, g = (nt - 8) & 1;
          if (j == 0) store_rows(acc, (u16*)(ws + E_KCRAW) + (size_t)tok0 * 256 + g * 128, 256, smem, h);
          else if (j == 1) store_rows(acc, (u16*)(ws + E_VCRAW) + (size_t)tok0 * 256 + g * 128, 256, smem, h);
          else if (j == 2) {
            norm_rope128<false>(acc, gl, c64, s64, t, h);
            store_rows(acc, (u16*)(ws + E_KS) + (size_t)tok0 * 256 + g * 128, 256, smem, h);
          } else if (j == 3) store_vt(acc, (u16*)(ws + E_VST) + (size_t)((b * 2 + g) * 128) * SEQ + t, SEQ, h);
          else if (j == 4) {
            norm_rope128<false>(acc, gl, c64, s64, t, h);
            store_rows(acc, (u16*)(ws + E_KW) + (size_t)tok0 * 256 + g * 128, 256, smem, h);
          } else store_vt(acc, (u16*)(ws + E_VWT) + (size_t)((b * 2 + g) * 128) * SEQ + t, SEQ, h);
        } else if (nt == 20) {
          float* ag = (float*)(ws + E_AG) + (size_t)tok * 32;
#pragma unroll
          for (int ig = 0; ig < 3; ++ig)
            *(f32x4*)(ag + 8 * ig + 4 * h) =
                mkf4(acc[0][4 * ig], acc[0][4 * ig + 1], acc[0][4 * ig + 2], acc[0][4 * ig + 3]);
        } else if (nt < 29) store_rows(acc, zb + (size_t)tok0 * DM + 128 * (nt - 21), DM, smem, h);
        else if (nt < 37) {
          const int isk = nt >= 33;
          RopeTab64 tb;
          rope64_load(tb, c32, s32, t, h);
          norm64(acc, gl, h);
          rope64_apply(acc, 0, tb);
          rope64_apply(acc, 1, tb);
          store_rows(acc, (u16*)(ws + (isk ? E_BK : E_BQ)) + (size_t)tok0 * 512 + 128 * (isk ? nt - 33 : nt - 29), 512, smem, h);
        } else if (nt < 41) store_vt(acc, (u16*)(ws + E_BVT) + (size_t)((b * 4 + (nt - 37)) * 128) * SEQ + t, SEQ, h);
        else if (nt < 45) store_rows(acc, zb + (size_t)tok0 * DM + 1024 + 128 * (nt - 41), DM, smem, h);
        else if (nt < 49) {
          norm128(acc, gl, h);
          store_rows(acc, (u16*)(ws + E_MQ) + (size_t)tok0 * 512 + 128 * (nt - 45), 512, smem, h);
        } else store_rows(acc, zb + (size_t)tok0 * DM + 1536 + 128 * (nt - 49), DM, smem, h);
      } else {
        if (nt < 12) {
          norm_rope128<false>(acc, gl, c64, s64, t, h);
          store_rows(acc, (u16*)(ws + O_CQ) + (size_t)tok0 * 1536 + 128 * nt, 1536, smem, h);
        } else if (nt < 16) {
          norm_rope128<false>(acc, gl, c64, s64, t, h);
          store_rows(acc, (u16*)(ws + O_CK) + (size_t)tok0 * 512 + 128 * (nt - 12), 512, smem, h);
        } else if (nt < 20) store_vt(acc, (u16*)(ws + O_CVT) + (size_t)((b * 4 + (nt - 16)) * 128) * SEQ + t, SEQ, h);
        else if (nt < 28) {
          RopeTab64 tb;
          rope64_load(tb, c32, s32, t, h);
          rope64_apply(acc, 0, tb);
          rope64_apply(acc, 1, tb);
          store_rows(acc, (u16*)(ws + O_IQ) + (size_t)tok0 * 1024 + 128 * (nt - 20), 1024, smem, h);
        } else if (nt == 28) {
          RopeTab64 tb;
          rope64_load(tb, c32, s32, t, h);
          rope64_apply(acc, 0, tb);
          u16* ik = (u16*)(ws + O_IK) + (size_t)tok * 64;
#pragma unroll
          for (int q = 0; q < 2; ++q)
#pragma unroll
            for (int ig = 0; ig < 4; ++ig) {
              u32x2 o;
              o.x = pk2(acc[q][4 * ig], acc[q][4 * ig + 1]);
              o.y = pk2(acc[q][4 * ig + 2], acc[q][4 * ig + 3]);
              *(u32x2*)(ik + 32 * q + 8 * ig + 4 * h) = o;
            }
          float* iw = (float*)(ws + O_IW) + (size_t)tok * 16;
#pragma unroll
          for (int ig = 0; ig < 2; ++ig)
            *(f32x4*)(iw + 8 * ig + 4 * h) = mkf4(acc[2][4 * ig] * 0.03125f, acc[2][4 * ig + 1] * 0.03125f,
                                                          acc[2][4 * ig + 2] * 0.03125f, acc[2][4 * ig + 3] * 0.03125f);
        } else if (nt < 41) store_rows(acc, zb + (size_t)tok0 * DM + 128 * (nt - 29), DM, smem, h);
        else if (nt < 45) {
          norm128(acc, gl, h);
          store_rows(acc, (u16*)(ws + O_MQ) + (size_t)tok0 * 512 + 128 * (nt - 41), 512, smem, h);
        } else store_rows(acc, zb + (size_t)tok0 * DM + 1536 + 128 * (nt - 45), DM, smem, h);
      }
    };
    gemm_block<true>(hy, rowp, 128, wtin, DM, mt * 256, nt * 128, smem, epi, gsrc, (!par && nt >= 29 && nt < 37) ? 63 : 127);
  }
  if (layer == 0) {
    const u16* memn = (const u16*)(ws + OFF_MEMN);
    for (int it = bid; it < 4 * 2 * 8; it += G) {
      const int li = it >> 4, mt = (it >> 3) & 1, nt = it & 7;
      const u16* wt = (const u16*)(ws + OFF_WKVT) + (size_t)li * 1024 * DM;
      auto rowp = [&](int m) __attribute__((always_inline)) { return (u32)m * (u32)DM; };
      auto epi = [&](f32x16(&acc)[4], int row, int h, int tok0) __attribute__((always_inline)) {
        const int b = row >> 8, slot = row & 255;
        if (nt < 4) {
          norm128(acc, (const float*)(smem + GAIN_OFF), h);
          store_plain(acc, (u16*)(ws + OFF_MEMK) + ((size_t)li * 512 + row) * 512 + nt * 128, h);
        } else {
          store_vt(acc, (u16*)(ws + OFF_MEMVT) + (size_t)(((li * 2 + b) * 4 + (nt - 4)) * 128) * 256 + slot, 256, h);
        }
      };
      gemm_block<true>(memn, rowp, 128, wt, DM, mt * 256, nt * 128, smem, epi, nt < 4 ? p.mem_qk_gain + (li * 2 + 1) * 128 : nullptr);
    }
  }
}

DI void phase_outproj(const Params& p, int layer, char* smem, const XcdInfo xc) {
  const int G = gridDim.x, bid = blockIdx.x;
  const u16* y = (const u16*)(ows(p.ws) + OFF_HY);
  const u16* wt = (const u16*)(ows(p.ws) + OFF_WTOUT);
  const float* xin = (const float*)ows((char*)(layer == 0 ? p.x : p.out));
  float* xo = (float*)ows((char*)p.out);
  const int mcount = (64 - xc.xi + xc.nx - 1) / xc.nx;
  const int nslots = ((mcount + 1) >> 1) * 2 * 16;
  for (int it = xc.lrank; it < nslots; it += xc.nloc) {
    const int grp = it >> 5, rem = it & 31;
    const int nt = rem >> 1, ml = 2 * grp + (rem & 1);
    if (ml >= mcount) continue;
    const int mt = xc.xi + ml * xc.nx;
    auto rowp = [&](int m) __attribute__((always_inline)) { return (u32)m * (u32)DM; };
    auto epi = [&](f32x16(&acc)[4], int tok, int h, int tok0) __attribute__((always_inline)) {
      const int tid = otid(), lane = tid & 63, w = tid >> 6, r = lane & 31;
      float* wb = (float*)smem + w * (32 * 132);
#pragma unroll
      for (int q = 0; q < 4; ++q)
#pragma unroll
        for (int ig = 0; ig < 4; ++ig)
          *(f32x4*)(wb + r * 132 + 32 * q + 8 * ig + 4 * h) =
              mkf4(acc[q][4 * ig], acc[q][4 * ig + 1], acc[q][4 * ig + 2], acc[q][4 * ig + 3]);
      __builtin_amdgcn_fence(__ATOMIC_SEQ_CST, "workgroup");
      __builtin_amdgcn_wave_barrier();
      const size_t o0 = (size_t)tok0 * DM + nt * 128 + (lane & 31) * 4;
#pragma unroll
      for (int hb = 0; hb < 2; ++hb) {
        f32x4 xv[8];
#pragma unroll
        for (int k = 0; k < 8; ++k) {
          const int row = (8 * hb + k) * 2 + (lane >> 5);
          xv[k] = *(const f32x4*)(xin + o0 + (size_t)row * DM);
        }
#pragma unroll
        for (int k = 0; k < 8; ++k) {
          const int row = (8 * hb + k) * 2 + (lane >> 5);
          const f32x4 a = *(const f32x4*)(wb + row * 132 + (lane & 31) * 4);
          *(f32x4*)(xo + o0 + (size_t)row * DM) = xv[k] + a;
        }
        __builtin_amdgcn_sched_barrier(0);
      }
      __builtin_amdgcn_fence(__ATOMIC_SEQ_CST, "workgroup");
      __builtin_amdgcn_wave_barrier();
    };
    gemm_block<true>(y, rowp, 128, wt, DM, mt * 256, nt * 128, smem, epi);
  }
}

DI void cmp_rowdec(int m, int& b, int& c, int& g) {
  const int mm = m < 2044 ? m : 0;
  b = mm / 1022;
  const int rem = mm - b * 1022;
  c = rem >> 1;
  g = rem & 1;
}
DI void mlp1_tiles(const Params& p, char* smem) {
  const int G = gridDim.x, bid = blockIdx.x;
  char* ws = ows(p.ws);
  for (int it = bid; it < 32; it += G) {
    const int kv = it >> 4, mt = (it >> 1) & 7, nt = it & 1;
    const u16* raw = (const u16*)(ws + (kv ? E_VCRAW : E_KCRAW));
    const u16* wt = (const u16*)(ws + OFF_W1T) + (size_t)kv * 256 * 4096;
    const float* cb = (const float*)(ws + OFF_CBIAS) + kv * 256 + nt * 128;
    u16* hid = (u16*)(ws + E_HID) + (size_t)kv * 2048 * 256;
    auto rowp = [&](int m) __attribute__((always_inline)) {
      int b, c, g;
      cmp_rowdec(m, b, c, g);
      return (u32)((b * SEQ + 16 * c) * 256 + g * 128);
    };
    auto epi = [&](f32x16(&acc)[4], int m, int h, int tok0) __attribute__((always_inline)) {
#pragma unroll
      for (int q = 0; q < 4; ++q)
#pragma unroll
        for (int ig = 0; ig < 4; ++ig) {
          const f32x4 bb = *(const f32x4*)(cb + 32 * q + 8 * ig + 4 * h);
          acc[q][4 * ig] = siluf(acc[q][4 * ig] + bb.x);
          acc[q][4 * ig + 1] = siluf(acc[q][4 * ig + 1] + bb.y);
          acc[q][4 * ig + 2] = siluf(acc[q][4 * ig + 2] + bb.z);
          acc[q][4 * ig + 3] = siluf(acc[q][4 * ig + 3] + bb.w);
        }
      store_plain(acc, hid + (size_t)m * 256 + nt * 128, h);
    };
    gemm_block<false>(raw, rowp, 256, wt, 4096, mt * 256, nt * 128, smem, epi);
  }
}
DI void phase_mlp2(const Params& p, int layer, char* smem) {
  const int G = gridDim.x, bid = blockIdx.x;
  const int e = layer >> 1;
  char* ws = ows(p.ws);
  const float* c64 = (const float*)(ws + OFF_COS64);
  const float* s64 = (const float*)(ws + OFF_SIN64);
  for (int it = bid; it < 16; it += G) {
    const int kv = it >> 3, mt = it & 7;
    const u16* hid = (const u16*)(ws + E_HID) + (size_t)kv * 2048 * 256;
    const u16* wt = (const u16*)(ws + OFF_W2T) + (size_t)kv * 128 * 256;
    auto rowp = [&](int m) __attribute__((always_inline)) { return (u32)m * 256u; };
    auto epi = [&](f32x16(&acc)[4], int m, int h, int tok0) __attribute__((always_inline)) {
      int b, c, g;
      cmp_rowdec(m, b, c, g);
      if (m < 2044) {
        if (kv == 0) {
          norm_rope128<false>(acc, (const float*)(smem + GAIN_OFF), c64, s64, 16 * c + 31, h);
          store_plain(acc, (u16*)(ws + E_KC) + ((size_t)(b * 512 + c)) * 256 + g * 128, h);
        } else {
          store_vt(acc, (u16*)(ws + E_VCT) + (size_t)((b * 2 + g) * 128) * 512 + c, 512, h);
        }
      }
    };
    gemm_block<true>(hid, rowp, 128, wt, 256, mt * 256, 0, smem, epi, kv == 0 ? p.nsa_qk_gain + (e * 4 + 1) * 128 : nullptr);
  }
}

struct FS {
  f32x16 O[4];
  float m, l;
};
constexpr int KS_LD = 136, VS_LD = 68;
constexpr int KS_BYTES = 64 * KS_LD * 2, VS_BYTES = 128 * VS_LD * 2;

struct TileRegs {
  u32x4 k[4], v[4];
};
DI void tile_gload_k(TileRegs& tr, const u16* __restrict__ kb, int ldk) {
  const int tid = otid();
#pragma unroll
  for (int i = 0; i < 4; ++i) {
    const int c = tid + 256 * i;
    tr.k[i] = *(const u32x4*)(kb + (size_t)(c >> 4) * ldk + (c & 15) * 8);
  }
}
DI void tile_gload_v(TileRegs& tr, const u16* __restrict__ vb, int ldv) {
  const int tid = otid();
#pragma unroll
  for (int i = 0; i < 4; ++i) {
    const int c = tid + 256 * i;
    tr.v[i] = *(const u32x4*)(vb + (size_t)(c >> 3) * ldv + (c & 7) * 8);
  }
}
DI void tile_sstore_k(const TileRegs& tr, u16* Ks) {
  const int tid = otid();
#pragma unroll
  for (int i = 0; i < 4; ++i) {
    const int c = tid + 256 * i;
    *(u32x4*)(Ks + (c >> 4) * KS_LD + (c & 15) * 8) = tr.k[i];
  }
}
DI void tile_sstore_v(const TileRegs& tr, u16* Vs) {
  const int tid = otid();
#pragma unroll
  for (int i = 0; i < 4; ++i) {
    const int c = tid + 256 * i;
    u32x2* d = (u32x2*)(Vs + (c >> 3) * VS_LD + (c & 7) * 8);
    d[0] = mku2(tr.v[i].x, tr.v[i].y);
    d[1] = mku2(tr.v[i].z, tr.v[i].w);
  }
}

template <int NS>
DI void qk_tile(const u16* Ks, int kcol0, const bf16x8 (&qf)[NS], f32x16 (&S)[2], int r, int h) {
#pragma unroll
  for (int kt = 0; kt < 2; ++kt) {
    zero16(S[kt]);
#pragma unroll
    for (int s = 0; s < NS; ++s) {
      const bf16x8 a = *(const bf16x8*)(Ks + (32 * kt + r) * KS_LD + kcol0 + 16 * s + 8 * h);
      S[kt] = MFMA32(a, qf[s], S[kt]);
    }
  }
}
DI void pv_tile(const u16* Vs, const f32x16 (&P)[2], f32x16 (&O)[4], int r, int h) {
#pragma unroll
  for (int kt = 0; kt < 2; ++kt)
#pragma unroll
    for (int s = 0; s < 2; ++s) {
      u32x4 pu;
      pu.x = pk2(P[kt][8 * s + 0], P[kt][8 * s + 1]);
      pu.y = pk2(P[kt][8 * s + 2], P[kt][8 * s + 3]);
      pu.z = pk2(P[kt][8 * s + 4], P[kt][8 * s + 5]);
      pu.w = pk2(P[kt][8 * s + 6], P[kt][8 * s + 7]);
      const bf16x8 pf = __builtin_bit_cast(bf16x8, pu);
#pragma unroll
      for (int dt = 0; dt < 4; ++dt) {
        const u16* vp = Vs + (32 * dt + r) * VS_LD + 32 * kt + 16 * s + 4 * h;
        const u32x2 lo = *(const u32x2*)(vp);
        const u32x2 hi = *(const u32x2*)(vp + 8);
        const u32x4 vu = mku4(lo.x, lo.y, hi.x, hi.y);
        O[dt] = MFMA32(__builtin_bit_cast(bf16x8, vu), pf, O[dt]);
      }
    }
}

DI bool tile_on(u32 e0, u32 e1, u32 e2, u32 e3, int j) {
  const u32 wsel = j < 32 ? e0 : (j < 64 ? e1 : (j < 96 ? e2 : e3));
  return (wsel >> (j & 31)) & 1u;
}
DI int tile_next(u32 e0, u32 e1, u32 e2, u32 e3, int j, int j_hi) {
  while (j <= j_hi && !tile_on(e0, e1, e2, e3, j)) ++j;
  return j;
}

constexpr int TILE_BYTES = KS_BYTES + VS_BYTES;
constexpr int SELM_OFF = 2 * TILE_BYTES + 64;

template <class Mask>
DI float softmax_tile(f32x16 (&S)[2], FS& st, float scale2, Mask& mk, int j, int h) {
  mk.begin(j);
  const bool need = Mask::ALWAYS ? true : (__ballot(mk.needs(j)) != 0ull);
  if (need) {
#pragma unroll
    for (int kt = 0; kt < 2; ++kt)
#pragma unroll
      for (int i = 0; i < 16; ++i) {
        const bool ok = mk.ok(kt, i, j * 64 + 32 * kt + crow(i, h));
        S[kt][i] = ok ? S[kt][i] : -INFINITY;
      }
  }
  float mraw = -INFINITY;
#pragma unroll
  for (int kt = 0; kt < 2; ++kt)
#pragma unroll
    for (int i = 0; i < 16; ++i) mraw = fmaxf(mraw, S[kt][i]);
  mraw = fmaxf(mraw, __shfl_xor(mraw, 32));
  const float mold = st.m;
  const float mnew = mraw * scale2;
  float mx = mold;
  if (__ballot(mnew > mold + 8.f) != 0ull) mx = fmaxf(mold, mnew);
  const float alpha = __builtin_amdgcn_exp2f(mold - mx);
  float rs = 0.f;
#pragma unroll
  for (int kt = 0; kt < 2; ++kt)
#pragma unroll
    for (int i = 0; i < 16; ++i) {
      const float pv = __builtin_amdgcn_exp2f(__builtin_fmaf(S[kt][i], scale2, -mx));
      S[kt][i] = pv;
      rs += pv;
    }
  st.l = st.l * alpha + rs;
  st.m = mx;
  return alpha;
}

template <int NS, class Mask>
DI void flash_tiles(FS& st, const bf16x8 (&qf)[NS], const u16* __restrict__ kbase, int ldk, int kcol0,
                    const u16* __restrict__ vtbase, int ldv, int j_lo, int j_hi, u32 e0, u32 e1, u32 e2, u32 e3,
                    float scale2, Mask& mk, char* smem) {
  const int lane = otid() & 63, r = lane & 31, h = lane >> 5;
  int j = tile_next(e0, e1, e2, e3, j_lo, j_hi);
  if (j > j_hi) return;
  TileRegs tr;
  tile_gload_k(tr, kbase + (size_t)j * 64 * ldk, ldk);
  tile_gload_v(tr, vtbase + j * 64, ldv);
  __syncthreads();
  tile_sstore_k(tr, (u16*)smem);
  tile_sstore_v(tr, (u16*)(smem + KS_BYTES));
  int jn = tile_next(e0, e1, e2, e3, j + 1, j_hi);
  if (jn <= j_hi) {
    tile_gload_k(tr, kbase + (size_t)jn * 64 * ldk, ldk);
    tile_gload_v(tr, vtbase + jn * 64, ldv);
  }
  int cur = 0;
  while (true) {
    __syncthreads();
    int jnn = j_hi + 1;
    if (jn <= j_hi) {
      char* nb = smem + (cur ^ 1) * TILE_BYTES;
      tile_sstore_k(tr, (u16*)nb);
      tile_sstore_v(tr, (u16*)(nb + KS_BYTES));
      jnn = tile_next(e0, e1, e2, e3, jn + 1, j_hi);
      if (jnn <= j_hi) {
        tile_gload_k(tr, kbase + (size_t)jnn * 64 * ldk, ldk);
        tile_gload_v(tr, vtbase + jnn * 64, ldv);
      }
    }
    const u16* Ks = (const u16*)(smem + cur * TILE_BYTES);
    const u16* Vs = (const u16*)(smem + cur * TILE_BYTES + KS_BYTES);
    f32x16 S[2];
    __builtin_amdgcn_s_setprio(1);
    qk_tile<NS>(Ks, kcol0, qf, S, r, h);
    __builtin_amdgcn_s_setprio(0);
    const float alpha = softmax_tile(S, st, scale2, mk, j, h);
    if (__ballot(alpha != 1.f) != 0ull) {
#pragma unroll
      for (int dt = 0; dt < 4; ++dt)
#pragma unroll
        for (int i = 0; i < 16; ++i) st.O[dt][i] *= alpha;
    }
    __builtin_amdgcn_s_setprio(1);
    pv_tile(Vs, S, st.O, r, h);
    __builtin_amdgcn_s_setprio(0);
    if (jn > j_hi) break;
    j = jn;
    jn = jnn;
    cur ^= 1;
  }
}

struct MaskCausal {
  static constexpr bool ALWAYS = false;
  int t;
  DI void begin(int) {}
  DI bool needs(int j) const { return 64 * j + 63 > t; }
  DI bool ok(int, int, int key) const { return key <= t; }
};
struct MaskWin {
  static constexpr bool ALWAYS = false;
  int t;
  DI void begin(int) {}
  DI bool needs(int j) const { return 64 * j + 63 > t || 64 * j <= t - 512; }
  DI bool ok(int, int, int key) const { return key <= t && key > t - 512; }
};
struct MaskCmp {
  static constexpr bool ALWAYS = false;
  int cmax;
  DI void begin(int) {}
  DI bool needs(int j) const { return 64 * j + 63 > cmax; }
  DI bool ok(int, int, int key) const { return key <= cmax; }
};
struct MaskNone {
  static constexpr bool ALWAYS = false;
  DI void begin(int) {}
  DI bool needs(int) const { return false; }
  DI bool ok(int, int, int) const { return true; }
};
struct MaskSel {
  static constexpr bool ALWAYS = false;
  int t;
  u32 b0, b1, b2, b3;
  bool on;
  DI void begin(int j) { on = tile_on(b0, b1, b2, b3, j); }
  DI bool needs(int j) const { return !on || 64 * j + 63 > t; }
  DI bool ok(int, int, int key) const { return on && key <= t; }
};
struct MaskDsa {
  static constexpr bool ALWAYS = true;
  const u64* base;
  int sh;
  u32 lo, hi;
  DI void begin(int j) {
    const u64 w = base[(size_t)j * SEQ];
    lo = (u32)w >> sh;
    hi = (u32)(w >> 32) >> sh;
  }
  DI bool needs(int) const { return true; }
  DI bool ok(int kt, int i, int) const { return (((kt ? hi : lo) >> ((i & 3) + 8 * (i >> 2))) & 1u) != 0u; }
};

template <int NS>
DI void load_q(bf16x8 (&qf)[NS], const u16* __restrict__ qrow, int h) {
#pragma unroll
  for (int s = 0; s < NS; ++s) qf[s] = *(const bf16x8*)(qrow + 16 * s + 8 * h);
}
DI void fs_init(FS& st) {
#pragma unroll
  for (int i = 0; i < 4; ++i) zero16(st.O[i]);
  st.m = -3.0e38f;
  st.l = 0.f;
}
DI float fs_invl(const FS& st) {
  const float lt = st.l + __shfl_xor(st.l, 32);
  return lt > 0.f ? 1.f / lt : 0.f;
}

template <bool ACCUM>
DI void store_gated(const f32x16 (&O)[4], float coef, const u16* __restrict__ zrow, u16* __restrict__ yrow, int h) {
#pragma unroll
  for (int hb = 0; hb < 2; ++hb) {
    u32x2 zz[8], yy[8];
#pragma unroll
    for (int k = 0; k < 8; ++k) {
      const int dt = 2 * hb + (k >> 2), ig = k & 3;
      const int d = 32 * dt + 8 * ig + 4 * h;
      zz[k] = *(const u32x2*)(zrow + d);
      if (ACCUM) yy[k] = *(const u32x2*)(yrow + d);
    }
#pragma unroll
    for (int k = 0; k < 8; ++k) {
      const int dt = 2 * hb + (k >> 2), ig = k & 3;
      const int d = 32 * dt + 8 * ig + 4 * h;
      const u32x2 z2 = zz[k];
      float v0 = coef * O[dt][4 * ig] * siluf(bflo(z2.x));
      float v1 = coef * O[dt][4 * ig + 1] * siluf(bfhi(z2.x));
      float v2 = coef * O[dt][4 * ig + 2] * siluf(bflo(z2.y));
      float v3 = coef * O[dt][4 * ig + 3] * siluf(bfhi(z2.y));
      if (ACCUM) {
        const u32x2 y2 = yy[k];
        v0 += bflo(y2.x);
        v1 += bfhi(y2.x);
        v2 += bflo(y2.y);
        v3 += bfhi(y2.y);
      }
      u32x2 o;
      o.x = pk2(v0, v1);
      o.y = pk2(v2, v3);
      *(u32x2*)(yrow + d) = o;
    }
    __builtin_amdgcn_sched_barrier(0);
  }
}

constexpr u32 ALLON = 0xffffffffu;

DI void item_diff(const Params& p, int layer, int id, char* smem) {
  char* ws = ows(p.ws);
  const int e = layer >> 1;
  const int qt = 127 - (id >> 3), b = (id >> 2) & 1, hd = id & 3;
  const int tid = otid(), lane = tid & 63, w = tid >> 6, r = lane & 31, h = lane >> 5;
  const int c = w >> 1;
  const int t = qt * 64 + 32 * (w & 1) + r;
  const size_t tok = (size_t)b * SEQ + t;
  bf16x8 qf[4];
  load_q<4>(qf, (const u16*)(ws + E_BQ) + tok * 512 + hd * 128 + c * 64, h);
  FS st;
  fs_init(st);
  MaskCausal mk{t};
  flash_tiles<4>(st, qf, (const u16*)(ws + E_BK) + (size_t)b * SEQ * 512 + hd * 128, 512, 64 * c,
                       (const u16*)(ws + E_BVT) + (size_t)((b * 4 + hd) * 128) * SEQ, SEQ, 0, qt, ALLON, ALLON, ALLON,
                       ALLON, 0.125f * LOG2E, mk, smem);
  const float il = fs_invl(st);
  float* ex = (float*)smem;
  __syncthreads();
  if (c == 1) {
#pragma unroll
    for (int dt = 0; dt < 4; ++dt)
#pragma unroll
      for (int i = 0; i < 16; ++i) ex[((w & 1) * 64 + dt * 16 + i) * 64 + lane] = st.O[dt][i] * il;
  }
  __syncthreads();
  if (c == 0) {
    const float lambda_init = 0.8f - 0.6f * expf(-0.3f * (float)layer);
    const float lam = ((const float*)(ws + OFF_MISC))[e] + lambda_init;
    float ss = 0.f;
#pragma unroll
    for (int dt = 0; dt < 4; ++dt)
#pragma unroll
      for (int i = 0; i < 16; ++i) {
        const float a = st.O[dt][i] * il - lam * ex[((w & 1) * 64 + dt * 16 + i) * 64 + lane];
        st.O[dt][i] = a;
        ss += a * a;
      }
    ss += __shfl_xor(ss, 32);
    const float rinv = rsqrtf(ss * (1.f / 128.f) + EPS) * (1.f - lambda_init);
    const float* sg = p.diff_subln_gain + e * 128;
#pragma unroll
    for (int dt = 0; dt < 4; ++dt)
#pragma unroll
      for (int ig = 0; ig < 4; ++ig) {
        const f32x4 g = *(const f32x4*)(sg + 32 * dt + 8 * ig + 4 * h);
        st.O[dt][4 * ig] *= g.x;
        st.O[dt][4 * ig + 1] *= g.y;
        st.O[dt][4 * ig + 2] *= g.z;
        st.O[dt][4 * ig + 3] *= g.w;
      }
    store_gated<false>(st.O, rinv, (const u16*)(ws + OFF_Z) + tok * DM + 1024 + hd * 128,
                       (u16*)(ws + OFF_HY) + tok * DM + 1024 + hd * 128, h);
  }
}

DI void item_win(const Params& p, int id, char* smem) {
  char* ws = ows(p.ws);
  const int qt = id >> 2, b = (id >> 1) & 1, g = id & 1;
  const int tid = otid(), lane = tid & 63, w = tid >> 6, r = lane & 31, h = lane >> 5;
  const int t = qt * 32 + 8 * w + (r & 7), hq = 4 * g + (r >> 3);
  const size_t tok = (size_t)b * SEQ + t;
  bf16x8 qf[8];
  load_q<8>(qf, (const u16*)(ws + E_QA) + tok * 1024 + hq * 128, h);
  FS st;
  fs_init(st);
  MaskWin mk{t};
  int lo = qt * 32 - 511;
  lo = lo < 0 ? 0 : lo >> 6;
  flash_tiles<8>(st, qf, (const u16*)(ws + E_KW) + (size_t)b * SEQ * 256 + g * 128, 256, 0,
                       (const u16*)(ws + E_VWT) + (size_t)((b * 2 + g) * 128) * SEQ, SEQ, lo, (qt * 32 + 31) >> 6, ALLON,
                       ALLON, ALLON, ALLON, 0.08838834764831845f * LOG2E, mk, smem);
  const float il = fs_invl(st);
  const float gate = sigmf(((const float*)(ws + E_AG))[tok * 32 + hq * 3 + 2]);
  store_gated<false>(st.O, il * gate, (const u16*)(ws + OFF_Z) + tok * DM + hq * 128, (u16*)(ws + OFF_HY) + tok * DM + hq * 128,
                     h);
}

DI void item_sel(const Params& p, int id, char* smem) {
  char* ws = ows(p.ws);
  const int qt = 255 - (id >> 2), b = (id >> 1) & 1, g = id & 1;
  const int tid = otid(), lane = tid & 63, w = tid >> 6, r = lane & 31, h = lane >> 5;
  const int t = qt * 32 + 8 * w + (r & 7), hq = 4 * g + (r >> 3);
  const size_t tok = (size_t)b * SEQ + t;
  __syncthreads();
  const u32x4 sm4 = *(const u32x4*)((const u32*)(smem + SELM_OFF) + (8 * w + (r & 7)) * 4);
  u32 u0 = sm4.x, u1 = sm4.y, u2 = sm4.z, u3 = sm4.w;
#pragma unroll
  for (int o = 1; o <= 4; o <<= 1) {
    u0 |= __shfl_xor(u0, o);
    u1 |= __shfl_xor(u1, o);
    u2 |= __shfl_xor(u2, o);
    u3 |= __shfl_xor(u3, o);
  }
  u32* us = (u32*)(smem + 2 * TILE_BYTES);
  __syncthreads();
  if (lane == 0) {
    us[w * 4 + 0] = u0;
    us[w * 4 + 1] = u1;
    us[w * 4 + 2] = u2;
    us[w * 4 + 3] = u3;
  }
  __syncthreads();
  u0 = us[0] | us[4] | us[8] | us[12];
  u1 = us[1] | us[5] | us[9] | us[13];
  u2 = us[2] | us[6] | us[10] | us[14];
  u3 = us[3] | us[7] | us[11] | us[15];
  bf16x8 qf[8];
  load_q<8>(qf, (const u16*)(ws + E_QA) + tok * 1024 + hq * 128, h);
  FS st;
  fs_init(st);
  MaskSel mk{t, sm4.x, sm4.y, sm4.z, sm4.w, false};
  flash_tiles<8>(st, qf, (const u16*)(ws + E_KS) + (size_t)b * SEQ * 256 + g * 128, 256, 0,
                       (const u16*)(ws + E_VST) + (size_t)((b * 2 + g) * 128) * SEQ, SEQ, 0, (qt * 32 + 31) >> 6, u0, u1, u2,
                       u3, 0.08838834764831845f * LOG2E, mk, smem);
  const float il = fs_invl(st);
  const float gate = sigmf(((const float*)(ws + E_AG))[tok * 32 + hq * 3 + 1]);
  store_gated<true>(st.O, il * gate, (const u16*)(ws + OFF_Z) + tok * DM + hq * 128, (u16*)(ws + OFF_HY) + tok * DM + hq * 128,
                    h);
}

DI void item_cmp(const Params& p, int id, char* smem) {
  char* ws = ows(p.ws);
  const int qt = 255 - (id >> 2), b = (id >> 1) & 1, g = id & 1;
  const int tid = otid(), lane = tid & 63, w = tid >> 6, r = lane & 31, h = lane >> 5;
  const int tl = 8 * w + (r & 7);
  const int t = qt * 32 + tl, hq = 4 * g + (r >> 3);
  const size_t tok = (size_t)b * SEQ + t;
  const float scale2 = 0.08838834764831845f * LOG2E;
  u16* Ks = (u16*)smem;
  u16* Vs = (u16*)(smem + KS_BYTES);
  float* imp = (float*)(smem + KS_BYTES + VS_BYTES);
  __syncthreads();
  for (int i = tid; i < 32 * 132; i += NTHREADS) imp[i] = 0.f;
  bf16x8 qf[8];
  load_q<8>(qf, (const u16*)(ws + E_QA) + tok * 1024 + hq * 128, h);
  FS st;
  fs_init(st);
  MaskCmp mk{t >= 31 ? ((t - 31) >> 4) : -1};
  const int j_hi = qt >> 5;
  const u16* kbase = (const u16*)(ws + E_KC) + (size_t)b * 512 * 256 + g * 128;
  const u16* vtbase = (const u16*)(ws + E_VCT) + (size_t)((b * 2 + g) * 128) * 512;
  for (int j = 0; j <= j_hi; ++j) {
    TileRegs tr;
    tile_gload_k(tr, kbase + (size_t)j * 64 * 256, 256);
    __syncthreads();
    tile_sstore_k(tr, Ks);
    __syncthreads();
    f32x16 S[2];
    qk_tile<8>(Ks, 0, qf, S, r, h);
    softmax_tile(S, st, scale2, mk, j, h);
  }
  const float il = fs_invl(st);
  const float mfin = st.m;
  for (int j = 0; j <= j_hi; ++j) {
    TileRegs tr;
    tile_gload_k(tr, kbase + (size_t)j * 64 * 256, 256);
    tile_gload_v(tr, vtbase + j * 64, 512);
    __syncthreads();
    tile_sstore_k(tr, Ks);
    tile_sstore_v(tr, Vs);
    __syncthreads();
    f32x16 S[2];
    qk_tile<8>(Ks, 0, qf, S, r, h);
#pragma unroll
    for (int kt = 0; kt < 2; ++kt) {
#pragma unroll
      for (int i = 0; i < 16; ++i) {
        const int key = j * 64 + 32 * kt + crow(i, h);
        S[kt][i] = key <= mk.cmax ? __builtin_amdgcn_exp2f(S[kt][i] * scale2 - mfin) * il : 0.f;
      }
#pragma unroll
      for (int ig = 0; ig < 4; ++ig) {
        float vm = S[kt][4 * ig] + S[kt][4 * ig + 1] + S[kt][4 * ig + 2] + 0.5f * S[kt][4 * ig + 3];
        float vn = 0.5f * S[kt][4 * ig + 3];
        vm += __shfl_xor(vm, 8);
        vn += __shfl_xor(vn, 8);
        vm += __shfl_xor(vm, 16);
        vn += __shfl_xor(vn, 16);
        if ((r >> 3) == 0) {
          const int jj = 16 * j + 8 * kt + 2 * ig + h;
          atomicAdd(&imp[tl * 132 + jj], vm);
          atomicAdd(&imp[tl * 132 + jj + 1], vn);
        }
      }
    }
    pv_tile(Vs, S, st.O, r, h);
  }
  const float gate = sigmf(((const float*)(ws + E_AG))[tok * 32 + hq * 3 + 0]);
  store_gated<true>(st.O, gate, (const u16*)(ws + OFF_Z) + tok * DM + hq * 128, (u16*)(ws + OFF_HY) + tok * DM + hq * 128, h);
  __syncthreads();
  for (int q = 0; q < 8; ++q) {
    const int tl2 = 8 * w + q;
    const int t2 = qt * 32 + tl2;
    const int cur = t2 >> 6;
    const int j0 = lane, j1 = lane + 64;
    float v0 = j0 > cur ? -1e30f : ((j0 == 0 || j0 >= cur - 1) ? 1e9f : imp[tl2 * 132 + j0]);
    float v1 = j1 > cur ? -1e30f : ((j1 >= cur - 1) ? 1e9f : imp[tl2 * 132 + j1]);
    u32 m0 = 0, m1 = 0, m2 = 0, m3 = 0;
    for (int rd = 0; rd < 16; ++rd) {
      float bv = v0;
      int bj = j0;
      if (v1 > v0) {
        bv = v1;
        bj = j1;
      }
#pragma unroll
      for (int o = 32; o >= 1; o >>= 1) {
        const float ov = __shfl_xor(bv, o);
        const int oj = __shfl_xor(bj, o);
        if (ov > bv || (ov == bv && oj < bj)) {
          bv = ov;
          bj = oj;
        }
      }
      const u32 bit = 1u << (bj & 31);
      if (bj < 32) m0 |= bit;
      else if (bj < 64) m1 |= bit;
      else if (bj < 96) m2 |= bit;
      else m3 |= bit;
      if (bj == j0) v0 = -3e38f;
      if (bj == j1) v1 = -3e38f;
    }
    const int nb = cur + 1;
    const u32 k0 = nb >= 32 ? ALLON : ((1u << nb) - 1u);
    const u32 k1 = nb >= 64 ? ALLON : (nb <= 32 ? 0u : ((1u << (nb - 32)) - 1u));
    const u32 k2 = nb >= 96 ? ALLON : (nb <= 64 ? 0u : ((1u << (nb - 64)) - 1u));
    const u32 k3 = nb >= 128 ? ALLON : (nb <= 96 ? 0u : ((1u << (nb - 96)) - 1u));
    if (lane == 0)
      *(u32x4*)((u32*)(smem + SELM_OFF) + tl2 * 4) = mku4(m0 & k0, m1 & k1, m2 & k2, m3 & k3);
  }
}

DI void item_mem(const Params& p, int layer, int id, char* smem) {
  char* ws = ows(p.ws);
  const int par = layer & 1;
  const int qt = id >> 3, b = (id >> 2) & 1, hm = id & 3;
  const int tid = otid(), lane = tid & 63, w = tid >> 6, r = lane & 31, h = lane >> 5;
  const int t = qt * 128 + 32 * w + r;
  const size_t tok = (size_t)b * SEQ + t;
  bf16x8 qf[8];
  load_q<8>(qf, (const u16*)(ws + (par ? O_MQ : E_MQ)) + tok * 512 + hm * 128, h);
  FS st;
  fs_init(st);
  MaskNone mk;
  flash_tiles<8>(st, qf, (const u16*)(ws + OFF_MEMK) + ((size_t)layer * 512 + b * 256) * 512 + hm * 128, 512, 0,
                       (const u16*)(ws + OFF_MEMVT) + (size_t)(((layer * 2 + b) * 4 + hm) * 128) * 256, 256, 0, 3, ALLON,
                       ALLON, ALLON, ALLON, 0.08838834764831845f * LOG2E, mk, smem);
  const float il = fs_invl(st);
  store_gated<false>(st.O, il, (const u16*)(ws + OFF_Z) + tok * DM + 1536 + hm * 128,
                     (u16*)(ws + OFF_HY) + tok * DM + 1536 + hm * 128, h);
}

DI void item_dsa(const Params& p, int id, char* smem) {
  char* ws = ows(p.ws);
  const int qt = 63 - id / 24, rem = id % 24, b = rem / 12, hd = rem % 12, g = hd / 3;
  const int tid = otid(), lane = tid & 63, w = tid >> 6, r = lane & 31, h = lane >> 5;
  const int t = qt * 128 + 32 * w + r;
  const size_t tok = (size_t)b * SEQ + t;
  bf16x8 qf[8];
  load_q<8>(qf, (const u16*)(ws + O_CQ) + tok * 1536 + hd * 128, h);
  FS st;
  fs_init(st);
  MaskDsa mk{(const u64*)(ws + O_DMASK) + (size_t)b * 128 * SEQ + t, 4 * h, 0u, 0u};
  flash_tiles<8>(st, qf, (const u16*)(ws + O_CK) + (size_t)b * SEQ * 512 + g * 128, 512, 0,
                       (const u16*)(ws + O_CVT) + (size_t)((b * 4 + g) * 128) * SEQ, SEQ, 0, 2 * qt + 1, ALLON, ALLON, ALLON,
                       ALLON, 0.08838834764831845f * LOG2E, mk, smem);
  const float il = fs_invl(st);
  store_gated<false>(st.O, il, (const u16*)(ws + OFF_Z) + tok * DM + hd * 128, (u16*)(ws + OFF_HY) + tok * DM + hd * 128, h);
}

DI size_t sc_row(int b, int t) {
  const int q = t >> 7;
  return (size_t)b * SC_PER_B + (size_t)16384 * (q * (q + 1) / 2) + (size_t)(t & 127) * (128 * (q + 1));
}
constexpr int QS_LD = 1032;
DI void item_idx(const Params& p, int b, int qt32, int ch, char* smem) {
  char* ws = ows(p.ws);
  u16* Qs = (u16*)smem;
  float* wsm = (float*)(smem + 32 * QS_LD * 2);
  const int tid = otid(), lane = tid & 63, w = tid >> 6, r = lane & 31, h = lane >> 5;
  const int q0 = qt32 * 32;
  const int Lq = 128 * ((q0 >> 7) + 1);
  __syncthreads();
  {
    const u16* iq = (const u16*)(ws + O_IQ) + ((size_t)b * SEQ + q0) * 1024;
#pragma unroll
    for (int i = 0; i < 16; ++i) {
      const int c = tid + 256 * i;
      *(u32x4*)(Qs + (c >> 7) * QS_LD + (c & 127) * 8) = *(const u32x4*)(iq + (size_t)(c >> 7) * 1024 + (c & 127) * 8);
    }
    const float* iw = (const float*)(ws + O_IW) + ((size_t)b * SEQ + q0) * 16;
    for (int i = tid; i < 512; i += NTHREADS) wsm[i] = iw[i];
  }
  __syncthreads();
  const int key0 = ch * 512 + 128 * w;
  if (key0 >= Lq) return;
  const u16* ik = (const u16*)(ws + O_IK) + ((size_t)b * SEQ + key0) * 64;
  bf16x8 kf[4][4];
#pragma unroll
  for (int sub = 0; sub < 4; ++sub)
#pragma unroll
    for (int s = 0; s < 4; ++s) kf[sub][s] = *(const bf16x8*)(ik + (size_t)(32 * sub + r) * 64 + 16 * s + 8 * h);
  f32x16 acc[4];
#pragma unroll
  for (int i = 0; i < 4; ++i) zero16(acc[i]);
#pragma unroll 1
  for (int hh = 0; hh < 16; ++hh) {
    const float wv = wsm[r * 16 + hh];
    bf16x8 qf[4];
#pragma unroll
    for (int s = 0; s < 4; ++s) qf[s] = *(const bf16x8*)(Qs + r * QS_LD + hh * 64 + 16 * s + 8 * h);
#pragma unroll
    for (int sub = 0; sub < 4; ++sub) {
      f32x16 sx;
      zero16(sx);
      __builtin_amdgcn_s_setprio(1);
#pragma unroll
      for (int s = 0; s < 4; ++s) sx = MFMA32(kf[sub][s], qf[s], sx);
      __builtin_amdgcn_s_setprio(0);
#pragma unroll
      for (int i = 0; i < 16; ++i) acc[sub][i] += wv * fmaxf(sx[i], 0.f);
    }
  }
  const int t = q0 + r;
  u16* srow = (u16*)(ws + O_SC) + sc_row(b, t) + key0;
#pragma unroll
  for (int sub = 0; sub < 4; ++sub)
#pragma unroll
    for (int ig = 0; ig < 4; ++ig) {
      u16 hv[4];
#pragma unroll
      for (int q = 0; q < 4; ++q) {
        const _Float16 f = (_Float16)acc[sub][4 * ig + q];
        hv[q] = __builtin_bit_cast(u16, f);
      }
      u32x2 o;
      o.x = (u32)hv[0] | ((u32)hv[1] << 16);
      o.y = (u32)hv[2] | ((u32)hv[3] << 16);
      *(u32x2*)(srow + 32 * sub + 8 * ig + 4 * h) = o;
    }
}
DI void phase_idx(const Params& p, char* smem) {
  const int G = gridDim.x;
  for (int it = blockIdx.x; it < 2 * 2176; it += G) {
    const int b = it & 1;
    const int idx = it >> 1;
    int q4 = 0;
    while (q4 < 15 && 8 * (q4 + 1) * (q4 + 2) <= idx) ++q4;
    const int rem = idx - 8 * q4 * (q4 + 1);
    const int ch = rem >> 4, qt32 = q4 * 16 + (rem & 15);
    item_idx(p, b, qt32, ch, smem);
  }
}

DI u32 okey(u32 hbits) { return (hbits & 0x8000u) ? (~hbits & 0xffffu) : (hbits | 0x8000u); }
DI void wave_lds_sync() {
  __builtin_amdgcn_fence(__ATOMIC_SEQ_CST, "workgroup");
  __builtin_amdgcn_wave_barrier();
}
DI int find_bin(const u32* hist, int lane, u32 target, u32& above) {
  const u32 c0 = hist[4 * lane], c1 = hist[4 * lane + 1], c2 = hist[4 * lane + 2], c3 = hist[4 * lane + 3];
  const u32 tot = c0 + c1 + c2 + c3;
  u32 suf = tot;
#pragma unroll
  for (int o = 1; o < 64; o <<= 1) {
    const u32 v = __shfl_down(suf, o);
    if (lane + o < 64) suf += v;
  }
  const u64 bal = __ballot(suf >= target);
  const int sl = 63 - __builtin_clzll(bal | 1ull);
  u32 a = suf - tot;
  int bin;
  if (a + c3 >= target) bin = 3;
  else {
    a += c3;
    if (a + c2 >= target) bin = 2;
    else {
      a += c2;
      if (a + c1 >= target) bin = 1;
      else {
        a += c1;
        bin = 0;
      }
    }
  }
  const int resb = __shfl(4 * lane + bin, sl);
  above = __shfl(a, sl);
  return resb;
}
DI void phase_select(const Params& p, char* smem) {
  char* ws = ows(p.ws);
  const int tid = otid(), lane = tid & 63, w = tid >> 6;
  u32* hist = (u32*)smem + w * 256;
  const int gw = blockIdx.x * 4 + w, nw = gridDim.x * 4;
  u64* dmask = (u64*)(ws + O_DMASK);
  for (int row = gw; row < NTOK; row += nw) {
    const int b = row & 1, t = SEQ - 1 - (row >> 1);
    const int L = t + 1;
    const u16* srow = (const u16*)(ws + O_SC) + sc_row(b, t);
    u32 T = 0, need = 0x7fffffffu;
    const bool all = L <= 256;
    if (!all) {
      const int nit = (L + 511) >> 9;
      wave_lds_sync();
#pragma unroll
      for (int i = 0; i < 4; ++i) hist[lane + 64 * i] = 0;
      wave_lds_sync();
      for (int it = 0; it < nit; ++it) {
        const int i0 = it * 512 + lane * 8;
        const u32x4 v = *(const u32x4*)(srow + i0);
        const u32 vv[4] = {v.x, v.y, v.z, v.w};
#pragma unroll
        for (int q = 0; q < 8; ++q) {
          const u32 k = okey((vv[q >> 1] >> (16 * (q & 1))) & 0xffffu);
          if (i0 + q <= t) atomicAdd(&hist[k >> 8], 1u);
        }
      }
      wave_lds_sync();
      u32 above1;
      const int b1 = find_bin(hist, lane, 256u, above1);
      wave_lds_sync();
#pragma unroll
      for (int i = 0; i < 4; ++i) hist[lane + 64 * i] = 0;
      wave_lds_sync();
      for (int it = 0; it < nit; ++it) {
        const int i0 = it * 512 + lane * 8;
        const u32x4 v = *(const u32x4*)(srow + i0);
        const u32 vv[4] = {v.x, v.y, v.z, v.w};
#pragma unroll
        for (int q = 0; q < 8; ++q) {
          const u32 k = okey((vv[q >> 1] >> (16 * (q & 1))) & 0xffffu);
          if (i0 + q <= t && (int)(k >> 8) == b1) atomicAdd(&hist[k & 255u], 1u);
        }
      }
      wave_lds_sync();
      u32 above2;
      const int b2 = find_bin(hist, lane, 256u - above1, above2);
      T = ((u32)b1 << 8) | (u32)b2;
      need = 256u - above1 - above2;
    }
    const int ktmax = 2 * (t >> 7) + 1;
    const int nit3 = (ktmax + 1 + 7) >> 3;
    u32 tie_base = 0;
    for (int it = 0; it < nit3; ++it) {
      const int i0 = it * 512 + lane * 8;
      const u32x4 v = *(const u32x4*)(srow + i0);
      const u32 vv[4] = {v.x, v.y, v.z, v.w};
      u32 kk[8];
      u32 tc = 0;
#pragma unroll
      for (int q = 0; q < 8; ++q) {
        kk[q] = okey((vv[q >> 1] >> (16 * (q & 1))) & 0xffffu);
        if (i0 + q <= t && kk[q] == T) ++tc;
      }
      u32 inc = tc;
#pragma unroll
      for (int o = 1; o < 64; o <<= 1) {
        const u32 x = __shfl_up(inc, o);
        if (lane >= o) inc += x;
      }
      u32 rank = tie_base + inc - tc;
      tie_base += __shfl(inc, 63);
      u32 byte = 0;
#pragma unroll
      for (int q = 0; q < 8; ++q) {
        const bool valid = i0 + q <= t;
        bool s = false;
        if (valid) {
          if (all || kk[q] > T) s = true;
          else if (kk[q] == T) {
            s = rank < need;
            ++rank;
          }
        }
        byte |= (s ? 1u : 0u) << q;
      }
      const int sh = 8 * (lane & 7);
      u32 wlo = sh < 32 ? (byte << sh) : 0u;
      u32 whi = sh >= 32 ? (byte << (sh - 32)) : 0u;
#pragma unroll
      for (int o = 1; o <= 4; o <<= 1) {
        wlo |= __shfl_xor(wlo, o);
        whi |= __shfl_xor(whi, o);
      }
      const int kt = it * 8 + (lane >> 3);
      if ((lane & 7) == 0 && kt <= ktmax) dmask[((size_t)b * 128 + kt) * SEQ + t] = ((u64)whi << 32) | (u64)wlo;
    }
  }
}


#define XB_TMO      128
#define XB_XCNT(j)  (256  + 64 * (j))
#define XB_XSUB(j)  (1280 + 64 * (j))
#define XB_XGEN(j)  (2304 + 64 * (j))
#define XB_TOP      3328
#define XB_TOPGEN   3392
#define XCD_BAR_WORDS 3456
#define XB_SPIN_CAP (1u << 22)
#define LAS __attribute__((address_space(3)))
DI unsigned xb_ld(unsigned* p) { return __hip_atomic_load(p, __ATOMIC_RELAXED, __HIP_MEMORY_SCOPE_AGENT); }
DI unsigned xb_add(unsigned* p, unsigned v) { return __hip_atomic_fetch_add(p, v, __ATOMIC_RELAXED, __HIP_MEMORY_SCOPE_AGENT); }
DI unsigned xb_xcc_id() { return (unsigned)__builtin_amdgcn_s_getreg((3 << 11) | 20) & 0xFu; }
#define XB_SPIN(cond, bar) do { unsigned _sp = 0; while (cond) { __builtin_amdgcn_s_sleep(1); \
    if ((++_sp & 255u) == 0u) { if (xb_ld(&(bar)[XB_TMO])) break; if (_sp > XB_SPIN_CAP) { atomicAdd(&(bar)[XB_TMO], 1u); break; } } } } while (0)
struct XcdBarrier {
  unsigned* bar;
  unsigned x;
  volatile LAS unsigned* st;
};
DI void xcd_barrier_complete(unsigned* bar, unsigned x, unsigned& nloc, unsigned& nx) {
  const unsigned G = gridDim.x * gridDim.y * gridDim.z;
  unsigned sum, cnt, mine, sp = 0u;
  for (;;) {
    sum = 0u; cnt = 0u; mine = 0u;
#pragma unroll 1
    for (unsigned j = 0; j < 16; ++j) { const unsigned c = xb_ld(&bar[XB_XCNT(j)]); sum += c; cnt += (c > 0u) ? 1u : 0u; mine = (j == x) ? c : mine; }
    if (sum == G) break;
    __builtin_amdgcn_s_sleep(1);
    if ((++sp & 255u) == 0u) { if (xb_ld(&bar[XB_TMO])) break; if (sp > XB_SPIN_CAP) { atomicAdd(&bar[XB_TMO], 1u); break; } }
  }
  nloc = mine > 0u ? mine : 1u; nx = cnt > 0u ? cnt : 1u;
}
DI void xcd_barrier(const XcdBarrier& b) {
  asm volatile("s_waitcnt vmcnt(0)" ::: "memory");
  __syncthreads();
  if (__builtin_amdgcn_workitem_id_x() == 0) {
    unsigned* bar = (unsigned*)ows((char*)b.bar);
    __builtin_amdgcn_s_waitcnt(0);
    unsigned nloc = b.st[0], nx = b.st[1];
    if (nloc == 0u) { xcd_barrier_complete(bar, b.x, nloc, nx); b.st[0] = nloc; b.st[1] = nx; }
    const unsigned old = xb_add(&bar[XB_XSUB(b.x)], 1u);
    const unsigned gen = old / nloc;
    if (old + 1u == (gen + 1u) * nloc) {
      __builtin_amdgcn_fence(__ATOMIC_RELEASE, "agent");
      asm volatile("s_waitcnt vmcnt(0)" ::: "memory");
      const unsigned og = xb_add(&bar[XB_TOP], 1u);
      const unsigned tg = og / nx;
      if (og + 1u == (tg + 1u) * nx) xb_add(&bar[XB_TOPGEN], 1u);
      else XB_SPIN(xb_ld(&bar[XB_TOPGEN]) == tg, bar);
      __builtin_amdgcn_fence(__ATOMIC_ACQUIRE, "agent");
      xb_add(&bar[XB_XGEN(b.x)], 1u);
      asm volatile("s_waitcnt vmcnt(0)" ::: "memory");
    } else {
      XB_SPIN(xb_ld(&bar[XB_XGEN(b.x)]) == gen, bar);
      __builtin_amdgcn_fence(__ATOMIC_ACQUIRE, "agent");
      asm volatile("s_waitcnt vmcnt(0)" ::: "memory");
    }
  }
  __syncthreads();
}

DI XcdInfo xcd_info(const XcdBarrier& b, int* s_tmp) {
  __syncthreads();
  if (__builtin_amdgcn_workitem_id_x() == 0) {
    int xi = 0;
    unsigned* bar = (unsigned*)ows((char*)b.bar);
#pragma unroll 1
    for (unsigned j = 0; j < 16; ++j) {
      const unsigned c = xb_ld(&bar[XB_XCNT(j)]);
      if (j < b.x && c > 0u) ++xi;
    }
    s_tmp[0] = xi;
  }
  __syncthreads();
  XcdInfo r;
  r.xi = s_tmp[0];
  r.nloc = (int)b.st[0];
  r.nx = (int)b.st[1];
  r.lrank = (int)b.st[2];
  return r;
}

DI void run_phase(const Params& p, int ph, char* smem, int* s_item, const XcdBarrier& xb) {
  int layer, lp;
  if (ph < 6) { layer = 0; lp = ph; }
  else if (ph < 12) { layer = 1; lp = ph - 6; }
  else if (ph < 18) { layer = 2; lp = ph - 12; }
  else { layer = 3; lp = ph - 18; }
  int* ctr = (int*)(ows(p.ws) + OFF_CTR) + layer * 8;
  if (!(layer & 1)) {
    switch (lp) {
      case 0: phase_prep(p, layer, smem); break;
      case 1: phase_proj(p, layer, smem, xcd_info(xb, s_item)); break;
      case 2: {
        mlp1_tiles(p, smem);
        int it;
        while ((it = next_item(ctr + 0, s_item)) < 2560) {
          if (it < 1024) item_diff(p, layer, it, smem);
          else if (it < 2048) item_win(p, it - 1024, smem);
          else item_mem(p, layer, it - 2048, smem);
        }
      } break;
      case 3: phase_mlp2(p, layer, smem); break;
      case 4: {
        int it;
        while ((it = next_item(ctr + 1, s_item)) < 1024) {
          item_cmp(p, it, smem);
          item_sel(p, it, smem);
        }
      } break;
      default: phase_outproj(p, layer, smem, xcd_info(xb, s_item)); break;
    }
  } else {
    switch (lp) {
      case 0: phase_prep(p, layer, smem); break;
      case 1: phase_proj(p, layer, smem, xcd_info(xb, s_item)); break;
      case 2: {
        phase_idx(p, smem);
        int it;
        while ((it = next_item(ctr + 0, s_item)) < 512) item_mem(p, layer, it, smem);
      } break;
      case 3: phase_select(p, smem); break;
      case 4: {
        int it;
        while ((it = next_item(ctr + 1, s_item)) < 1536) item_dsa(p, it, smem);
      } break;
      default: phase_outproj(p, layer, smem, xcd_info(xb, s_item)); break;
    }
  }
}

constexpr int SMEM_BYTES = 2 * TILE_BYTES + 64 + 512;
constexpr int N_PHASES = 24;

__global__ void __launch_bounds__(NTHREADS, 2) trunk_megakernel(Params p) {
  __shared__ __attribute__((aligned(16))) char smem[SMEM_BYTES];
  __shared__ int s_item;
  __shared__ u32x4 xb_words;
  cg::grid_group grid = cg::this_grid();
  XcdBarrier xb;
  xb.bar = (unsigned*)(p.ws + OFF_BAR);
  xb.x = xb_xcc_id();
  xb.st = (volatile LAS unsigned*)&xb_words;
  if (__builtin_amdgcn_workitem_id_x() == 0) {
    xb.st[0] = 0u;
    xb.st[1] = 0u;
  }
  __syncthreads();
  if (__builtin_amdgcn_workitem_id_x() == 0) xb.st[2] = xb_add(&xb.bar[XB_XCNT(xb.x)], 1u);
  if (p.ph_end < 0) grid.sync();
  if (p.ph_begin == 0) phase_prep0_extra(p, smem);
  for (int ph = p.ph_begin; ph < p.ph_end; ++ph) {
    run_phase(p, ph, smem, &s_item, xb);
    if (ph + 1 < p.ph_end) xcd_barrier(xb);
  }
}

extern "C" void kernel_launch(void* const* d_in, const int* in_sizes, int n_in, void* d_out, int out_size, void* d_ws,
                              size_t ws_size, hipStream_t stream) {
  static int grid_blocks = 0;
  if (!grid_blocks) {
    int dev = 0, cus = 0, per_cu = 0;
    (void)hipGetDevice(&dev);
    (void)hipDeviceGetAttribute(&cus, hipDeviceAttributeMultiprocessorCount, dev);
    (void)hipOccupancyMaxActiveBlocksPerMultiprocessor(&per_cu, trunk_megakernel, NTHREADS, 0);
    if (per_cu > 2) per_cu = 2;
    if (per_cu < 1) per_cu = 1;
    grid_blocks = cus * per_cu;
  }
  Params p;
  memset(&p, 0, sizeof(p));
  p.x = (const float*)d_in[0];
  p.mem = (const float*)d_in[1];
  p.norm_gain = (const float*)d_in[2];
  p.mem_norm_gain = (const float*)d_in[3];
  p.mem_w_kv = (const float*)d_in[4];
  p.mem_qk_gain = (const float*)d_in[5];
  p.w_out = (const float*)d_in[6];
  p.even_w_in = (const float*)d_in[7];
  p.nsa_qk_gain = (const float*)d_in[8];
  p.nsa_cmp_pos = (const float*)d_in[9];
  p.nsa_cmp_w1 = (const float*)d_in[10];
  p.nsa_cmp_w2 = (const float*)d_in[11];
  p.diff_qk_gain = (const float*)d_in[12];
  p.diff_lambda = (const float*)d_in[13];
  p.diff_subln_gain = (const float*)d_in[14];
  p.odd_w_in = (const float*)d_in[15];
  p.dsa_qk_gain = (const float*)d_in[16];
  p.out = (float*)d_out;
  p.ws = (char*)d_ws;
  p.ph_begin = 0;
  p.ph_end = N_PHASES;
  (void)hipMemsetAsync(d_ws, 0, 4096, stream);
  (void)hipMemsetAsync((char*)d_ws + OFF_BAR, 0, 16384, stream);
  void* args[] = {&p};
  hipError_t err = hipLaunchCooperativeKernel((void*)trunk_megakernel, dim3(grid_blocks), dim3(NTHREADS), args, 0, stream);
  if (err != hipSuccess) fprintf(stderr, "cooperative launch failed: %s (grid %d)\n", hipGetErrorString(err), grid_blocks);
}
```

```cpp
#include <hip/hip_runtime.h>
#include <hip/hip_cooperative_groups.h>
#include <stdint.h>
#include <stdio.h>
#include <string.h>
#include <type_traits>
namespace cg = cooperative_groups;

#define DI __device__ __forceinline__
typedef unsigned short u16;
typedef unsigned int u32;
typedef unsigned long long u64;
typedef __attribute__((ext_vector_type(8))) short bf16x8;
typedef __attribute__((ext_vector_type(16))) float f32x16;
typedef __attribute__((ext_vector_type(2))) float f32x2;
typedef __attribute__((ext_vector_type(4))) float f32x4;
typedef __attribute__((ext_vector_type(4))) unsigned int u32x4;
typedef __attribute__((ext_vector_type(2))) unsigned int u32x2;
typedef __attribute__((ext_vector_type(2))) __bf16 bf16x2;
#define MFMA32(a, b, c) __builtin_amdgcn_mfma_f32_32x32x16_bf16((a), (b), (c), 0, 0, 0)

constexpr int NB = 2, SEQ = 8192, DM = 2048, NTOK = NB * SEQ;
constexpr int EVEN_IN = 6680, ODD_IN = 6224, EVEN_NT = 53, ODD_NT = 49;
constexpr float EPS = 1e-6f;
constexpr float LOG2E = 1.4426950408889634f;
constexpr int NTHREADS = 256;

constexpr size_t MiB = 1ull << 20;
constexpr size_t OFF_CTR = 0;
constexpr size_t OFF_MISC = 4096;
constexpr size_t OFF_COS64 = 8192;
constexpr size_t OFF_SIN64 = OFF_COS64 + 2 * MiB;
constexpr size_t OFF_COS32 = OFF_SIN64 + 2 * MiB;
constexpr size_t OFF_SIN32 = OFF_COS32 + 1 * MiB;
constexpr size_t OFF_MEMN = OFF_SIN32 + 1 * MiB;
constexpr size_t OFF_MEMK = OFF_MEMN + 2 * MiB;
constexpr size_t OFF_MEMVT = OFF_MEMK + 2 * MiB;
constexpr size_t OFF_WKVT = OFF_MEMVT + 2 * MiB;
constexpr size_t OFF_WTIN = OFF_WKVT + 16 * MiB;
constexpr size_t OFF_WTOUT = OFF_WTIN + 27 * MiB;
constexpr size_t OFF_W1T = OFF_WTOUT + 8 * MiB;
constexpr size_t OFF_W2T = OFF_W1T + 4 * MiB;
constexpr size_t OFF_CBIAS = OFF_W2T + 128 * 1024;
constexpr size_t OFF_CBPART = OFF_CBIAS + 4096;
constexpr size_t OFF_BAR = OFF_CBPART + 131072;
constexpr size_t OFF_HY = OFF_CBIAS + 4096 + 8192 + (MiB - 128 * 1024 - 4096 - 8192 - 8192);
constexpr size_t OFF_Z = OFF_HY + 64 * MiB;
constexpr size_t OFF_L = OFF_Z + 64 * MiB;
constexpr size_t E_QA = OFF_L;
constexpr size_t E_KCRAW = E_QA + 32 * MiB;
constexpr size_t E_VCRAW = E_KCRAW + 8 * MiB;
constexpr size_t E_KS = E_VCRAW + 8 * MiB;
constexpr size_t E_VST = E_KS + 8 * MiB;
constexpr size_t E_KW = E_VST + 8 * MiB;
constexpr size_t E_VWT = E_KW + 8 * MiB;
constexpr size_t E_AG = E_VWT + 8 * MiB;
constexpr size_t E_BQ = E_AG + 2 * MiB;
constexpr size_t E_BK = E_BQ + 16 * MiB;
constexpr size_t E_BVT = E_BK + 16 * MiB;
constexpr size_t E_MQ = E_BVT + 16 * MiB;
constexpr size_t E_KC = E_MQ + 16 * MiB;
constexpr size_t E_VCT = E_KC + MiB / 2;
constexpr size_t E_HID = E_VCT + MiB / 2;
constexpr size_t E_SELM = E_HID + 2 * MiB;
constexpr size_t E_END = E_SELM + MiB / 2;
constexpr size_t O_CQ = OFF_L;
constexpr size_t O_CK = O_CQ + 48 * MiB;
constexpr size_t O_CVT = O_CK + 16 * MiB;
constexpr size_t O_IQ = O_CVT + 16 * MiB;
constexpr size_t O_IK = O_IQ + 32 * MiB;
constexpr size_t O_IW = O_IK + 2 * MiB;
constexpr size_t O_MQ = O_IW + 1 * MiB;
constexpr size_t O_DMASK = O_MQ + 16 * MiB;
constexpr size_t O_SC = O_DMASK + 16 * MiB;
constexpr size_t SC_PER_B = 16384ull * (64 * 65 / 2);
constexpr size_t O_END = O_SC + 2 * SC_PER_B * 2;

struct Params {
  const float *x, *mem, *norm_gain, *mem_norm_gain, *mem_w_kv, *mem_qk_gain, *w_out, *even_w_in, *nsa_qk_gain,
      *nsa_cmp_pos, *nsa_cmp_w1, *nsa_cmp_w2, *diff_qk_gain, *diff_lambda, *diff_subln_gain, *odd_w_in, *dsa_qk_gain;
  float* out;
  char* ws;
  int ph_begin, ph_end;
};

DI u16 f2bf(float x) {
  u32 u = __float_as_uint(x);
  u += 0x7fffu + ((u >> 16) & 1u);
  return (u16)(u >> 16);
}
DI u32x4 mku4(u32 a, u32 b, u32 c, u32 d) { u32x4 r = {a, b, c, d}; return r; }
DI u32x2 mku2(u32 a, u32 b) { u32x2 r = {a, b}; return r; }
DI f32x4 mkf4(float a, float b, float c, float d) { f32x4 r = {a, b, c, d}; return r; }
DI float bf2f(u16 v) { return __uint_as_float(((u32)v) << 16); }
DI u32 pk2(float a, float b) {
  f32x2 v = {a, b};
  bf16x2 r = __builtin_convertvector(v, bf16x2);
  return __builtin_bit_cast(u32, r);
}
DI float bflo(u32 v) { return __uint_as_float(v << 16); }
DI float bfhi(u32 v) { return __uint_as_float(v & 0xffff0000u); }
DI float siluf(float v) { return v / (1.f + __expf(-v)); }
DI float sigmf(float v) { return 1.f / (1.f + __expf(-v)); }
DI int otid() {
  int t = __builtin_amdgcn_workitem_id_x();
  asm volatile("" : "+v"(t));
  return t;
}
DI char* ows(char* w) {
  u64 v = (u64)(uintptr_t)w;
  asm volatile("" : "+s"(v));
  return (char*)(__attribute__((address_space(1))) char*)v;
}
DI int crow(int i, int h) { return (i & 3) + 8 * (i >> 2) + 4 * h; }
DI void zero16(f32x16& a) {
#pragma unroll
  for (int i = 0; i < 16; ++i) a[i] = 0.f;
}

DI int next_item(int* ctr, int* s_item) {
  __syncthreads();
  if (otid() == 0) *s_item = atomicAdd(ctr, 1);
  __syncthreads();
  return *s_item;
}

DI void tt_load(f32x4 (&v)[8], const float* __restrict__ src, int lds, int col0, int nvalid, int k0) {
  const int tid = otid();
  const int n4 = (tid & 15) * 4;
#pragma unroll
  for (int i = 0; i < 8; ++i) {
    const int k = (tid >> 4) + 16 * i;
    v[i] = mkf4(0.f, 0.f, 0.f, 0.f);
    if (n4 < nvalid) v[i] = *(const f32x4*)(src + (size_t)(k0 + k) * lds + col0 + n4);
  }
}
DI void tt_store(const f32x4 (&v)[8], u16* __restrict__ dst, int K, int n0, int k0, float* sm) {
  const int tid = otid();
  __syncthreads();
  {
    const int n4 = (tid & 15) * 4;
#pragma unroll
    for (int i = 0; i < 8; ++i) {
      const int k = (tid >> 4) + 16 * i;
      sm[k * 65 + n4 + 0] = v[i].x;
      sm[k * 65 + n4 + 1] = v[i].y;
      sm[k * 65 + n4 + 2] = v[i].z;
      sm[k * 65 + n4 + 3] = v[i].w;
    }
  }
  __syncthreads();
  {
    const int n = tid >> 2, ks = (tid & 3) * 32;
    u32x4* d = (u32x4*)(dst + (size_t)(n0 + n) * K + k0 + ks);
#pragma unroll
    for (int q = 0; q < 4; ++q) {
      u32 o[4];
#pragma unroll
      for (int j = 0; j < 4; ++j)
        o[j] = pk2(sm[(ks + 8 * q + 2 * j) * 65 + n], sm[(ks + 8 * q + 2 * j + 1) * 65 + n]);
      d[q] = mku4(o[0], o[1], o[2], o[3]);
    }
  }
}
DI void transpose_tile(const float* __restrict__ src, int lds, int col0, int nvalid, u16* __restrict__ dst, int K,
                       int n0, int k0, float* sm) {
  f32x4 v[8];
  tt_load(v, src, lds, col0, nvalid, k0);
  tt_store(v, dst, K, n0, k0, sm);
}

DI void rmsnorm_row(const float* __restrict__ src, const float* __restrict__ gain, u16* __restrict__ dst) {
  const int lane = otid() & 63;
  f32x4 v[8];
  float ss = 0.f;
#pragma unroll
  for (int i = 0; i < 8; ++i) {
    v[i] = *(const f32x4*)(src + (i * 64 + lane) * 4);
    ss += v[i].x * v[i].x + v[i].y * v[i].y + v[i].z * v[i].z + v[i].w * v[i].w;
  }
#pragma unroll
  for (int o = 32; o >= 1; o >>= 1) ss += __shfl_xor(ss, o);
  const float rinv = rsqrtf(ss * (1.f / 2048.f) + EPS);
#pragma unroll
  for (int i = 0; i < 8; ++i) {
    const f32x4 g = *(const f32x4*)(gain + (i * 64 + lane) * 4);
    u32x2 o;
    o.x = pk2(v[i].x * rinv * g.x, v[i].y * rinv * g.y);
    o.y = pk2(v[i].z * rinv * g.z, v[i].w * rinv * g.w);
    *(u32x2*)(dst + (i * 64 + lane) * 4) = o;
  }
}

DI void rmsnorm_row2(const float* __restrict__ src0, const float* __restrict__ src1, const float* __restrict__ gain,
                     u16* __restrict__ dst0, u16* __restrict__ dst1) {
  const int lane = otid() & 63;
  f32x4 v[8], u[8];
#pragma unroll
  for (int i = 0; i < 8; ++i) {
    v[i] = *(const f32x4*)(src0 + (i * 64 + lane) * 4);
    u[i] = *(const f32x4*)(src1 + (i * 64 + lane) * 4);
  }
  float ss = 0.f, st = 0.f;
#pragma unroll
  for (int i = 0; i < 8; ++i) {
    ss += v[i].x * v[i].x + v[i].y * v[i].y + v[i].z * v[i].z + v[i].w * v[i].w;
    st += u[i].x * u[i].x + u[i].y * u[i].y + u[i].z * u[i].z + u[i].w * u[i].w;
  }
#pragma unroll
  for (int o = 32; o >= 1; o >>= 1) {
    ss += __shfl_xor(ss, o);
    st += __shfl_xor(st, o);
  }
  const float rv = rsqrtf(ss * (1.f / 2048.f) + EPS), ru = rsqrtf(st * (1.f / 2048.f) + EPS);
#pragma unroll
  for (int i = 0; i < 8; ++i) {
    const f32x4 g = *(const f32x4*)(gain + (i * 64 + lane) * 4);
    u32x2 o;
    o.x = pk2(v[i].x * rv * g.x, v[i].y * rv * g.y);
    o.y = pk2(v[i].z * rv * g.z, v[i].w * rv * g.w);
    *(u32x2*)(dst0 + (i * 64 + lane) * 4) = o;
    o.x = pk2(u[i].x * ru * g.x, u[i].y * ru * g.y);
    o.y = pk2(u[i].z * ru * g.z, u[i].w * ru * g.w);
    *(u32x2*)(dst1 + (i * 64 + lane) * 4) = o;
  }
}
DI int even_src(int nt, int& valid) {
  valid = (nt == 20) ? 24 : 128;
  return nt <= 20 ? 128 * nt : 2584 + 128 * (nt - 21);
}
DI int odd_src(int nt, int& valid) {
  valid = (nt == 28) ? 80 : 128;
  return nt <= 28 ? 128 * nt : 3664 + 128 * (nt - 29);
}

DI void phase_prep(const Params& p, int layer, char* smem) {
  const int tid = otid(), G = gridDim.x, bid = blockIdx.x;
  const int par = layer & 1, e = layer >> 1;
  char* ws = ows(p.ws);
  float* sm = (float*)smem;
  const int gw = bid * 4 + (tid >> 6), nw = G * 4;
  {
    const float* xin = layer == 0 ? p.x : p.out;
    u16* hy = (u16*)(ws + OFF_HY);
    for (int row = gw; row < NTOK; row += 2 * nw) {
      const int row1 = row + nw;
      if (row1 < NTOK)
        rmsnorm_row2(xin + (size_t)row * DM, xin + (size_t)row1 * DM, p.norm_gain + layer * DM, hy + (size_t)row * DM,
                     hy + (size_t)row1 * DM);
      else
        rmsnorm_row(xin + (size_t)row * DM, p.norm_gain + layer * DM, hy + (size_t)row * DM);
    }
  }
  {
    u16* wtin = (u16*)(ws + OFF_WTIN);
    const int ntl = par ? ODD_NT : EVEN_NT;
    const float* win = par ? p.odd_w_in + (size_t)e * DM * ODD_IN : p.even_w_in + (size_t)e * DM * EVEN_IN;
    const int ldw = par ? ODD_IN : EVEN_IN;
    const int ntiles = ntl * 2 * 16;
    auto issue = [&](int it, f32x4(&vv)[8]) __attribute__((always_inline)) {
      const int kt = it & 15, n64 = it >> 4;
      int valid;
      const int sb = par ? odd_src(n64 >> 1, valid) : even_src(n64 >> 1, valid);
      const int half = n64 & 1;
      int nv = valid - 64 * half;
      nv = nv < 0 ? 0 : (nv > 64 ? 64 : nv);
      tt_load(vv, win, ldw, sb + 64 * half, nv, kt * 128);
    };
    f32x4 va[8];
    int it = bid;
    if (it < ntiles) issue(it, va);
    while (it < ntiles) {
      const int itn = it + G;
      f32x4 vb[8];
      if (itn < ntiles) issue(itn, vb);
      tt_store(va, wtin, DM, (it >> 4) * 64, (it & 15) * 128, sm);
#pragma unroll
      for (int i = 0; i < 8; ++i) va[i] = vb[i];
      it = itn;
    }
    u16* wtout = (u16*)(ws + OFF_WTOUT);
    const float* wo = p.w_out + (size_t)layer * DM * DM;
    for (int it = bid; it < 32 * 16; it += G)
      transpose_tile(wo, DM, (it >> 4) * 64, 64, wtout, DM, (it >> 4) * 64, (it & 15) * 128, sm);
  }
  if (!par) {
    u16* w1t = (u16*)(ws + OFF_W1T);
    for (int it = bid; it < 2 * 4 * 32; it += G) {
      const int kv = it >> 7, n64 = (it >> 5) & 3, kt = it & 31;
      transpose_tile(p.nsa_cmp_w1 + ((size_t)(e * 2 + kv)) * 4096 * 256, 256, n64 * 64, 64,
                     w1t + (size_t)kv * 256 * 4096, 4096, n64 * 64, kt * 128, sm);
    }
    u16* w2t = (u16*)(ws + OFF_W2T);
    for (int it = bid; it < 2 * 2 * 2; it += G) {
      const int kv = it >> 2, n64 = (it >> 1) & 1, kt = it & 1;
      transpose_tile(p.nsa_cmp_w2 + ((size_t)(e * 2 + kv)) * 256 * 128, 128, n64 * 64, 64, w2t + (size_t)kv * 128 * 256,
                     256, n64 * 64, kt * 128, sm);
    }
    float* cbp = (float*)(ws + OFF_CBPART);
    for (int it = bid; it < 128; it += G) {
      const int kv = it >> 6, chk = it & 63;
      const float* pe = p.nsa_cmp_pos + (size_t)(e * 2 + kv) * 4096 + chk * 64;
      const float* w1 = p.nsa_cmp_w1 + ((size_t)(e * 2 + kv)) * 4096 * 256 + (size_t)chk * 64 * 256;
      float a = 0.f;
#pragma unroll 16
      for (int f = 0; f < 64; ++f) a += pe[f] * w1[(size_t)f * 256 + tid];
      cbp[it * 256 + tid] = a;
    }
    if (bid == G - 1 && tid == 0) {
      const float* lv = p.diff_lambda + (size_t)e * 4 * 64;
      float s0 = 0.f, s1 = 0.f;
      for (int i = 0; i < 64; ++i) {
        s0 += lv[i] * lv[64 + i];
        s1 += lv[128 + i] * lv[192 + i];
      }
      ((float*)(ws + OFF_MISC))[e] = expf(s0) - expf(s1);
    }
  }
}

DI void phase_prep0_extra(const Params& p, char* smem) {
  const int tid = otid(), G = gridDim.x, bid = blockIdx.x;
  char* ws = ows(p.ws);
  float* sm = (float*)smem;
  const int gw = bid * 4 + (tid >> 6), nw = G * 4;
    float* c64 = (float*)(ws + OFF_COS64);
    float* s64 = (float*)(ws + OFF_SIN64);
    float* c32 = (float*)(ws + OFF_COS32);
    float* s32 = (float*)(ws + OFF_SIN32);
    for (int idx = bid * NTHREADS + tid; idx < SEQ * 64; idx += G * NTHREADS) {
      const int t = idx >> 6, i = idx & 63;
      const float inv = powf(10000.f, -(float)i / 64.f);
      const float ang = (float)t * inv;
      c64[idx] = cosf(ang);
      s64[idx] = sinf(ang);
      if (i < 32) {
        const float inv2 = powf(10000.f, -(float)i / 32.f);
        const float a2 = (float)t * inv2;
        c32[t * 32 + i] = cosf(a2);
        s32[t * 32 + i] = sinf(a2);
      }
    }
    u16* memn = (u16*)(ws + OFF_MEMN);
    for (int row = gw; row < NB * 256; row += nw)
      rmsnorm_row(p.mem + (size_t)row * DM, p.mem_norm_gain, memn + (size_t)row * DM);
    u16* wkvt = (u16*)(ws + OFF_WKVT);
    for (int it = bid; it < 4 * 16 * 16; it += G) {
      const int li = it >> 8, n64 = (it >> 4) & 15, kt = it & 15;
      transpose_tile(p.mem_w_kv + (size_t)li * DM * 1024, 1024, n64 * 64, 64, wkvt + (size_t)li * 1024 * DM, DM, n64 * 64,
                     kt * 128, sm);
    }
}

constexpr int GAIN_OFF = (256 + 128) * 72 * 2;
template <bool USTRIDE, int MG = 2, class RowF, class EpiF>
DI void gemm_block(const u16* __restrict__ abase, RowF rowoff, int ldk2, const u16* __restrict__ Wt, int K, int m0, int n0,
                   char* smem, EpiF epi, const float* __restrict__ gsrc = nullptr, int gmask = 127) {
  u16* As = (u16*)smem;
  u16* Ws = As + 256 * 72;
  const int tid = otid(), lane = tid & 63, w = tid >> 6, r = lane & 31, h = lane >> 5;
  if (gsrc) {
    __syncthreads();
    if (tid < 128) ((float*)(smem + GAIN_OFF))[tid] = gsrc[tid & gmask];
  }
  f32x16 acc[MG][4];
#pragma unroll
  for (int g = 0; g < MG; ++g)
#pragma unroll
    for (int i = 0; i < 4; ++i) zero16(acc[g][i]);
  const int kc = (tid & 7) * 8;
  u32 ao[4 * MG];
  if (USTRIDE) {
    ao[0] = rowoff(m0 + (tid >> 3));
    const u32 st32 = rowoff(32) - rowoff(0);
#pragma unroll
    for (int i = 1; i < 4 * MG; ++i) ao[i] = ao[0] + st32 * i;
  } else {
#pragma unroll
    for (int i = 0; i < 4 * MG; ++i) ao[i] = rowoff(m0 + (tid >> 3) + 32 * i);
  }
  const u16* wp0 = Wt + (size_t)(n0 + (tid >> 3)) * K + kc;
  const size_t wstep = (size_t)32 * K;
  const int lo = (tid >> 3) * 72 + kc;
  u32x4 ra[4 * MG], rw[4];
  {
    const int off = (kc >> 7) * ldk2 + (kc & 127);
#pragma unroll
    for (int i = 0; i < 4 * MG; ++i) ra[i] = *(const u32x4*)(abase + ao[i] + off);
#pragma unroll
    for (int i = 0; i < 4; ++i) rw[i] = *(const u32x4*)(wp0 + wstep * i);
  }
  for (int k0 = 0; k0 < K; k0 += 64) {
    __syncthreads();
#pragma unroll
    for (int i = 0; i < 4 * MG; ++i) *(u32x4*)(As + lo + 32 * 72 * i) = ra[i];
#pragma unroll
    for (int i = 0; i < 4; ++i) *(u32x4*)(Ws + lo + 32 * 72 * i) = rw[i];
    __syncthreads();
    if (k0 + 64 < K) {
      const int k = k0 + 64 + kc;
      const int off = (k >> 7) * ldk2 + (k & 127);
#pragma unroll
      for (int i = 0; i < 4 * MG; ++i) ra[i] = *(const u32x4*)(abase + ao[i] + off);
#pragma unroll
      for (int i = 0; i < 4; ++i) rw[i] = *(const u32x4*)(wp0 + wstep * i + k0 + 64);
    }
    __builtin_amdgcn_s_setprio(1);
#pragma unroll
    for (int s = 0; s < 4; ++s) {
      bf16x8 bq[MG];
#pragma unroll
      for (int g = 0; g < MG; ++g) bq[g] = *(const bf16x8*)(As + (32 * MG * w + 32 * g + r) * 72 + 16 * s + 8 * h);
#pragma unroll
      for (int nt = 0; nt < 4; ++nt) {
        const bf16x8 a = *(const bf16x8*)(Ws + (32 * nt + r) * 72 + 16 * s + 8 * h);
#pragma unroll
        for (int g = 0; g < MG; ++g) acc[g][nt] = MFMA32(a, bq[g], acc[g][nt]);
      }
    }
    __builtin_amdgcn_s_setprio(0);
  }
  __syncthreads();
  const int tok0 = __builtin_amdgcn_readfirstlane(m0 + 32 * MG * w);
#pragma unroll
  for (int g = 0; g < MG; ++g) epi(acc[g], tok0 + 32 * g + r, h, tok0 + 32 * g);
}

DI void norm128(f32x16 (&acc)[4], const float* gain, int h) {
  float ss = 0.f;
#pragma unroll
  for (int nt = 0; nt < 4; ++nt)
#pragma unroll
    for (int i = 0; i < 16; ++i) ss += acc[nt][i] * acc[nt][i];
  ss += __shfl_xor(ss, 32);
  const float rinv = rsqrtf(ss * (1.f / 128.f) + EPS);
#pragma unroll
  for (int nt = 0; nt < 4; ++nt) {
#pragma unroll
    for (int ig = 0; ig < 4; ++ig) {
      const f32x4 g = *(const f32x4*)(gain + 32 * nt + 8 * ig + 4 * h);
      acc[nt][4 * ig + 0] *= rinv * g.x;
      acc[nt][4 * ig + 1] *= rinv * g.y;
      acc[nt][4 * ig + 2] *= rinv * g.z;
      acc[nt][4 * ig + 3] *= rinv * g.w;
      if (ig & 1) __builtin_amdgcn_sched_barrier(0);
    }
  }
}
DI void norm64(f32x16 (&acc)[4], const float* gain, int h) {
  float rinv[2];
#pragma unroll
  for (int pp = 0; pp < 2; ++pp) {
    float ss = 0.f;
#pragma unroll
    for (int q = 0; q < 2; ++q)
#pragma unroll
      for (int i = 0; i < 16; ++i) ss += acc[2 * pp + q][i] * acc[2 * pp + q][i];
    ss += __shfl_xor(ss, 32);
    rinv[pp] = rsqrtf(ss * (1.f / 64.f) + EPS);
  }
#pragma unroll
  for (int q = 0; q < 2; ++q) {
#pragma unroll
    for (int ig = 0; ig < 4; ++ig) {
      const f32x4 g = *(const f32x4*)(gain + 32 * q + 8 * ig + 4 * h);
#pragma unroll
      for (int pp = 0; pp < 2; ++pp) {
        acc[2 * pp + q][4 * ig + 0] *= rinv[pp] * g.x;
        acc[2 * pp + q][4 * ig + 1] *= rinv[pp] * g.y;
        acc[2 * pp + q][4 * ig + 2] *= rinv[pp] * g.z;
        acc[2 * pp + q][4 * ig + 3] *= rinv[pp] * g.w;
      }
    }
    __builtin_amdgcn_sched_barrier(0);
  }
}
struct RopeTab128 {
  f32x4 c[4], s[4];
};
DI void rope128_load(RopeTab128& tb, int nt, const float* __restrict__ c64, const float* __restrict__ s64, int t, int h) {
#pragma unroll
  for (int ig = 0; ig < 4; ++ig) {
    const int d1 = 32 * nt + 8 * ig + 4 * h;
    tb.c[ig] = *(const f32x4*)(c64 + t * 64 + d1);
    tb.s[ig] = *(const f32x4*)(s64 + t * 64 + d1);
  }
}
DI void rope128_apply(f32x16 (&acc)[4], int nt, const RopeTab128& tb) {
#pragma unroll
  for (int ig = 0; ig < 4; ++ig)
#pragma unroll
    for (int q = 0; q < 4; ++q) {
      const int i = 4 * ig + q;
      const float c = tb.c[ig][q], sn = tb.s[ig][q];
      const float x1 = acc[nt][i], x2 = acc[nt + 2][i];
      acc[nt][i] = x1 * c - x2 * sn;
      acc[nt + 2][i] = x2 * c + x1 * sn;
    }
}
template <bool EARLY = true>
DI void norm_rope128(f32x16 (&acc)[4], const float* gl, const float* __restrict__ c64, const float* __restrict__ s64, int t, int h) {
  if (EARLY) {
    RopeTab128 tb;
    rope128_load(tb, 0, c64, s64, t, h);
    norm128(acc, gl, h);
    rope128_apply(acc, 0, tb);
    __builtin_amdgcn_sched_barrier(0);
    rope128_load(tb, 1, c64, s64, t, h);
    rope128_apply(acc, 1, tb);
  } else {
    norm128(acc, gl, h);
    __builtin_amdgcn_sched_barrier(0);
#pragma unroll
    for (int nt = 0; nt < 2; ++nt)
#pragma unroll
      for (int hb = 0; hb < 2; ++hb) {
        f32x4 c[2], sn[2];
#pragma unroll
        for (int k = 0; k < 2; ++k) {
          const int d1 = 32 * nt + 8 * (2 * hb + k) + 4 * h;
          c[k] = *(const f32x4*)(c64 + t * 64 + d1);
          sn[k] = *(const f32x4*)(s64 + t * 64 + d1);
        }
#pragma unroll
        for (int k = 0; k < 2; ++k)
#pragma unroll
          for (int q = 0; q < 4; ++q) {
            const int i = 4 * (2 * hb + k) + q;
            const float x1 = acc[nt][i], x2 = acc[nt + 2][i];
            acc[nt][i] = x1 * c[k][q] - x2 * sn[k][q];
            acc[nt + 2][i] = x2 * c[k][q] + x1 * sn[k][q];
          }
        __builtin_amdgcn_sched_barrier(0);
      }
  }
}
struct RopeTab64 {
  f32x4 c[4], s[4];
};
DI void rope64_load(RopeTab64& tb, const float* __restrict__ c32, const float* __restrict__ s32, int t, int h) {
#pragma unroll
  for (int ig = 0; ig < 4; ++ig) {
    const int d1 = 8 * ig + 4 * h;
    tb.c[ig] = *(const f32x4*)(c32 + t * 32 + d1);
    tb.s[ig] = *(const f32x4*)(s32 + t * 32 + d1);
  }
}
DI void rope64_apply(f32x16 (&acc)[4], int pp, const RopeTab64& tb) {
#pragma unroll
  for (int ig = 0; ig < 4; ++ig)
#pragma unroll
    for (int q = 0; q < 4; ++q) {
      const int i = 4 * ig + q;
      const float c = tb.c[ig][q], sn = tb.s[ig][q];
      const float x1 = acc[2 * pp][i], x2 = acc[2 * pp + 1][i];
      acc[2 * pp][i] = x1 * c - x2 * sn;
      acc[2 * pp + 1][i] = x2 * c + x1 * sn;
    }
}
DI void store_plain(const f32x16 (&acc)[4], u16* __restrict__ rowbase, int h) {
#pragma unroll
  for (int nt = 0; nt < 4; ++nt)
#pragma unroll
    for (int ig = 0; ig < 4; ++ig) {
      u32x2 o;
      o.x = pk2(acc[nt][4 * ig], acc[nt][4 * ig + 1]);
      o.y = pk2(acc[nt][4 * ig + 2], acc[nt][4 * ig + 3]);
      *(u32x2*)(rowbase + 32 * nt + 8 * ig + 4 * h) = o;
    }
}
constexpr int WB_LD = 136;
DI void store_rows(const f32x16 (&acc)[4], u16* __restrict__ base0, int ld, char* smem, int h) {
  const int tid = otid(), lane = tid & 63, w = tid >> 6, r = lane & 31;
  u16* wb = (u16*)smem + w * (32 * WB_LD);
#pragma unroll
  for (int nt = 0; nt < 4; ++nt)
#pragma unroll
    for (int ig = 0; ig < 4; ++ig) {
      u32x2 o;
      o.x = pk2(acc[nt][4 * ig], acc[nt][4 * ig + 1]);
      o.y = pk2(acc[nt][4 * ig + 2], acc[nt][4 * ig + 3]);
      *(u32x2*)(wb + r * WB_LD + 32 * nt + 8 * ig + 4 * h) = o;
    }
  __builtin_amdgcn_fence(__ATOMIC_SEQ_CST, "workgroup");
  __builtin_amdgcn_wave_barrier();
#pragma unroll
  for (int it = 0; it < 8; ++it) {
    const int row = it * 4 + (lane >> 4), ch = lane & 15;
    const u32x4 v = *(const u32x4*)(wb + row * WB_LD + ch * 8);
    *(u32x4*)(base0 + (size_t)row * ld + ch * 8) = v;
    if (it & 1) __builtin_amdgcn_sched_barrier(0);
  }
  __builtin_amdgcn_fence(__ATOMIC_SEQ_CST, "workgroup");
  __builtin_amdgcn_wave_barrier();
}
DI void store_vt(const f32x16 (&acc)[4], u16* __restrict__ base, size_t ld, int h) {
#pragma unroll
  for (int nt = 0; nt < 4; ++nt)
#pragma unroll
    for (int i = 0; i < 16; ++i) base[(size_t)(32 * nt + crow(i, h)) * ld] = f2bf(acc[nt][i]);
}

struct XcdInfo {
  int xi, nx, lrank, nloc;
};
DI void phase_proj(const Params& p, int layer, char* smem, const XcdInfo xc) {
  const int G = gridDim.x, bid = blockIdx.x;
  const int par = layer & 1, e = layer >> 1;
  char* ws = ows(p.ws);
  const u16* hy = (const u16*)(ws + OFF_HY);
  const u16* wtin = (const u16*)(ws + OFF_WTIN);
  const float* c64 = (const float*)(ws + OFF_COS64);
  const float* s64 = (const float*)(ws + OFF_SIN64);
  const float* c32 = (const float*)(ws + OFF_COS32);
  const float* s32 = (const float*)(ws + OFF_SIN32);
  u16* zb = (u16*)(ws + OFF_Z);
  if (!par && bid == G - 1) {
    const int tid = otid();
    const float* cbp = (const float*)(ws + OFF_CBPART);
    float* cb = (float*)(ws + OFF_CBIAS);
#pragma unroll
    for (int kv = 0; kv < 2; ++kv) {
      float a = 0.f;
#pragma unroll 16
      for (int c = 0; c < 64; ++c) a += cbp[(kv * 64 + c) * 256 + tid];
      cb[kv * 256 + tid] = a;
    }
  }
  const int ntl = par ? ODD_NT : EVEN_NT;
  const int ntiles = ntl * 64;
  const int mcount = (64 - xc.xi + xc.nx - 1) / xc.nx;
  const int nslots = ((mcount + 1) >> 1) * 2 * ntl;
  (void)ntiles;
  auto run_tile = [&](int it, int moff, auto mgtag) __attribute__((always_inline)) {
    const int grp = it / (2 * ntl), rem = it - grp * 2 * ntl;
    const int nt = rem >> 1, ml = 2 * grp + (rem & 1);
    if (ml >= mcount) return;
    const int mt = xc.xi + ml * xc.nx;
    auto rowp = [&](int m) __attribute__((always_inline)) { return (u32)m * (u32)DM; };
    const float* gsrc = nullptr;
    if (!par) {
      if (nt < 8) gsrc = p.nsa_qk_gain + (e * 4 + 0) * 128;
      else if (nt >= 12 && nt < 14) gsrc = p.nsa_qk_gain + (e * 4 + 2) * 128;
      else if (nt >= 16 && nt < 18) gsrc = p.nsa_qk_gain + (e * 4 + 3) * 128;
      else if (nt >= 29 && nt < 33) gsrc = p.diff_qk_gain + (e * 2 + 0) * 64;
      else if (nt >= 33 && nt < 37) gsrc = p.diff_qk_gain + (e * 2 + 1) * 64;
      else if (nt >= 45 && nt < 49) gsrc = p.mem_qk_gain + (layer * 2 + 0) * 128;
    } else {
      if (nt < 12) gsrc = p.dsa_qk_gain + (e * 2 + 0) * 128;
      else if (nt < 16) gsrc = p.dsa_qk_gain + (e * 2 + 1) * 128;
      else if (nt >= 41 && nt < 45) gsrc = p.mem_qk_gain + (layer * 2 + 0) * 128;
    }
    const float* gl = (const float*)(smem + GAIN_OFF);
    auto epi = [&](f32x16(&acc)[4], int tok, int h, int tok0) __attribute__((always_inline)) {
      const int t = tok & (SEQ - 1), b = tok >> 13;
      char* ws = ows(p.ws);
      u16* zb = (u16*)(ws + OFF_Z);
      if (!par) {
        if (nt < 8) {
          norm_rope128<false>(acc, gl, c64, s64, t, h);
          store_rows(acc, (u16*)(ws + E_QA) + (size_t)tok0 * 1024 + 128 * nt, 1024, smem, h);
        } else if (nt < 20) {
          const int j = (nt - 8) >> 1, g = (nt - 8) & 1;
          if (j == 0) store_rows(acc, (u16*)(ws + E_KCRAW) + (size_t)tok0 * 256 + g * 128, 256, smem, h);
          else if (j == 1) store_rows(acc, (u16*)(ws + E_VCRAW) + (size_t)tok0 * 256 + g * 128, 256, smem, h);
          else if (j == 2) {
            norm_rope128<false>(acc, gl, c64, s64, t, h);
            store_rows(acc, (u16*)(ws + E_KS) + (size_t)tok0 * 256 + g * 128, 256, smem, h);
          } else if (j == 3) store_vt(acc, (u16*)(ws + E_VST) + (size_t)((b * 2 + g) * 128) * SEQ + t, SEQ, h);
          else if (j == 4) {
            norm_rope128<false>(acc, gl, c64, s64, t, h);
            store_rows(acc, (u16*)(ws + E_KW) + (size_t)tok0 * 256 + g * 128, 256, smem, h);
          } else store_vt(acc, (u16*)(ws + E_VWT) + (size_t)((b * 2 + g) * 128) * SEQ + t, SEQ, h);
        } else if (nt == 20) {
          float* ag = (float*)(ws + E_AG) + (size_t)tok * 32;
#pragma unroll
          for (int ig = 0; ig < 3; ++ig)
            *(f32x4*)(ag + 8 * ig + 4 * h) =
                mkf4(acc[0][4 * ig], acc[0][4 * ig + 1], acc[0][4 * ig + 2], acc[0][4 * ig + 3]);
        } else if (nt < 29) store_rows(acc, zb + (size_t)tok0 * DM + 128 * (nt - 21), DM, smem, h);
        else if (nt < 37) {
          const int isk = nt >= 33;
          RopeTab64 tb;
          rope64_load(tb, c32, s32, t, h);
          norm64(acc, gl, h);
          rope64_apply(acc, 0, tb);
          rope64_apply(acc, 1, tb);
          store_rows(acc, (u16*)(ws + (isk ? E_BK : E_BQ)) + (size_t)tok0 * 512 + 128 * (isk ? nt - 33 : nt - 29), 512, smem, h);
        } else if (nt < 41) store_vt(acc, (u16*)(ws + E_BVT) + (size_t)((b * 4 + (nt - 37)) * 128) * SEQ + t, SEQ, h);
        else if (nt < 45) store_rows(acc, zb + (size_t)tok0 * DM + 1024 + 128 * (nt - 41), DM, smem, h);
        else if (nt < 49) {
          norm128(acc, gl, h);
          store_rows(acc, (u16*)(ws + E_MQ) + (size_t)tok0 * 512 + 128 * (nt - 45), 512, smem, h);
        } else store_rows(acc, zb + (size_t)tok0 * DM + 1536 + 128 * (nt - 49), DM, smem, h);
      } else {
        if (nt < 12) {
          norm_rope128<false>(acc, gl, c64, s64, t, h);
          store_rows(acc, (u16*)(ws + O_CQ) + (size_t)tok0 * 1536 + 128 * nt, 1536, smem, h);
        } else if (nt < 16) {
          norm_rope128<false>(acc, gl, c64, s64, t, h);
          store_rows(acc, (u16*)(ws + O_CK) + (size_t)tok0 * 512 + 128 * (nt - 12), 512, smem, h);
        } else if (nt < 20) store_vt(acc, (u16*)(ws + O_CVT) + (size_t)((b * 4 + (nt - 16)) * 128) * SEQ + t, SEQ, h);
        else if (nt < 28) {
          RopeTab64 tb;
          rope64_load(tb, c32, s32, t, h);
          rope64_apply(acc, 0, tb);
          rope64_apply(acc, 1, tb);
          store_rows(acc, (u16*)(ws + O_IQ) + (size_t)tok0 * 1024 + 128 * (nt - 20), 1024, smem, h);
        } else if (nt == 28) {
          RopeTab64 tb;
          rope64_load(tb, c32, s32, t, h);
          rope64_apply(acc, 0, tb);
          u16* ik = (u16*)(ws + O_IK) + (size_t)tok * 64;
#pragma unroll
          for (int q = 0; q < 2; ++q)
#pragma unroll
            for (int ig = 0; ig < 4; ++ig) {
              u32x2 o;
              o.x = pk2(acc[q][4 * ig], acc[q][4 * ig + 1]);
              o.y = pk2(acc[q][4 * ig + 2], acc[q][4 * ig + 3]);
              *(u32x2*)(ik + 32 * q + 8 * ig + 4 * h) = o;
            }
          float* iw = (float*)(ws + O_IW) + (size_t)tok * 16;
#pragma unroll
          for (int ig = 0; ig < 2; ++ig)
            *(f32x4*)(iw + 8 * ig + 4 * h) = mkf4(acc[2][4 * ig] * 0.03125f, acc[2][4 * ig + 1] * 0.03125f,
                                                          acc[2][4 * ig + 2] * 0.03125f, acc[2][4 * ig + 3] * 0.03125f);
        } else if (nt < 41) store_rows(acc, zb + (size_t)tok0 * DM + 128 * (nt - 29), DM, smem, h);
        else if (nt < 45) {
          norm128(acc, gl, h);
          store_rows(acc, (u16*)(ws + O_MQ) + (size_t)tok0 * 512 + 128 * (nt - 41), 512, smem, h);
        } else store_rows(acc, zb + (size_t)tok0 * DM + 1536 + 128 * (nt - 45), DM, smem, h);
      }
    };
    gemm_block<true, decltype(mgtag)::value>(hy, rowp, 128, wtin, DM, mt * 256 + moff, nt * 128, smem, epi, gsrc, (!par && nt >= 29 && nt < 37) ? 63 : 127);
    };
  const int nfull = (nslots / xc.nloc) * xc.nloc;
  for (int it = xc.lrank; it < nfull; it += xc.nloc) run_tile(it, 0, std::integral_constant<int, 2>{});
  const int nhalf = 2 * (nslots - nfull);
  for (int u = xc.lrank; u < nhalf; u += xc.nloc) run_tile(nfull + (u >> 1), 128 * (u & 1), std::integral_constant<int, 1>{});
  if (layer == 0) {
    const u16* memn = (const u16*)(ws + OFF_MEMN);
    for (int it = bid; it < 4 * 2 * 8; it += G) {
      const int li = it >> 4, mt = (it >> 3) & 1, nt = it & 7;
      const u16* wt = (const u16*)(ws + OFF_WKVT) + (size_t)li * 1024 * DM;
      auto rowp = [&](int m) __attribute__((always_inline)) { return (u32)m * (u32)DM; };
      auto epi = [&](f32x16(&acc)[4], int row, int h, int tok0) __attribute__((always_inline)) {
        const int b = row >> 8, slot = row & 255;
        if (nt < 4) {
          norm128(acc, (const float*)(smem + GAIN_OFF), h);
          store_plain(acc, (u16*)(ws + OFF_MEMK) + ((size_t)li * 512 + row) * 512 + nt * 128, h);
        } else {
          store_vt(acc, (u16*)(ws + OFF_MEMVT) + (size_t)(((li * 2 + b) * 4 + (nt - 4)) * 128) * 256 + slot, 256, h);
        }
      };
      gemm_block<true>(memn, rowp, 128, wt, DM, mt * 256, nt * 128, smem, epi, nt < 4 ? p.mem_qk_gain + (li * 2 + 1) * 128 : nullptr);
    }
  }
}

DI void phase_outproj(const Params& p, int layer, char* smem, const XcdInfo xc) {
  const int G = gridDim.x, bid = blockIdx.x;
  const u16* y = (const u16*)(ows(p.ws) + OFF_HY);
  const u16* wt = (const u16*)(ows(p.ws) + OFF_WTOUT);
  const float* xin = (const float*)ows((char*)(layer == 0 ? p.x : p.out));
  float* xo = (float*)ows((char*)p.out);
  const int mcount = (64 - xc.xi + xc.nx - 1) / xc.nx;
  const int nslots = ((mcount + 1) >> 1) * 2 * 16;
  for (int it = xc.lrank; it < nslots; it += xc.nloc) {
    const int grp = it >> 5, rem = it & 31;
    const int nt = rem >> 1, ml = 2 * grp + (rem & 1);
    if (ml >= mcount) continue;
    const int mt = xc.xi + ml * xc.nx;
    auto rowp = [&](int m) __attribute__((always_inline)) { return (u32)m * (u32)DM; };
    auto epi = [&](f32x16(&acc)[4], int tok, int h, int tok0) __attribute__((always_inline)) {
      const int tid = otid(), lane = tid & 63, w = tid >> 6, r = lane & 31;
      float* wb = (float*)smem + w * (32 * 132);
#pragma unroll
      for (int q = 0; q < 4; ++q)
#pragma unroll
        for (int ig = 0; ig < 4; ++ig)
          *(f32x4*)(wb + r * 132 + 32 * q + 8 * ig + 4 * h) =
              mkf4(acc[q][4 * ig], acc[q][4 * ig + 1], acc[q][4 * ig + 2], acc[q][4 * ig + 3]);
      __builtin_amdgcn_fence(__ATOMIC_SEQ_CST, "workgroup");
      __builtin_amdgcn_wave_barrier();
      const size_t o0 = (size_t)tok0 * DM + nt * 128 + (lane & 31) * 4;
#pragma unroll
      for (int hb = 0; hb < 4; ++hb) {
        f32x4 xv[4];
#pragma unroll
        for (int k = 0; k < 4; ++k) {
          const int row = (4 * hb + k) * 2 + (lane >> 5);
          xv[k] = *(const f32x4*)(xin + o0 + (size_t)row * DM);
        }
#pragma unroll
        for (int k = 0; k < 4; ++k) {
          const int row = (4 * hb + k) * 2 + (lane >> 5);
          const f32x4 a = *(const f32x4*)(wb + row * 132 + (lane & 31) * 4);
          *(f32x4*)(xo + o0 + (size_t)row * DM) = xv[k] + a;
        }
      }
      __builtin_amdgcn_fence(__ATOMIC_SEQ_CST, "workgroup");
      __builtin_amdgcn_wave_barrier();
    };
    gemm_block<true>(y, rowp, 128, wt, DM, mt * 256, nt * 128, smem, epi);
  }
}

DI void cmp_rowdec(int m, int& b, int& c, int& g) {
  const int mm = m < 2044 ? m : 0;
  b = mm / 1022;
  const int rem = mm - b * 1022;
  c = rem >> 1;
  g = rem & 1;
}
DI void mlp1_tiles(const Params& p, char* smem) {
  const int G = gridDim.x, bid = blockIdx.x;
  char* ws = ows(p.ws);
  for (int it = bid; it < 32; it += G) {
    const int kv = it >> 4, mt = (it >> 1) & 7, nt = it & 1;
    const u16* raw = (const u16*)(ws + (kv ? E_VCRAW : E_KCRAW));
    const u16* wt = (const u16*)(ws + OFF_W1T) + (size_t)kv * 256 * 4096;
    const float* cb = (const float*)(ws + OFF_CBIAS) + kv * 256 + nt * 128;
    u16* hid = (u16*)(ws + E_HID) + (size_t)kv * 2048 * 256;
    auto rowp = [&](int m) __attribute__((always_inline)) {
      int b, c, g;
      cmp_rowdec(m, b, c, g);
      return (u32)((b * SEQ + 16 * c) * 256 + g * 128);
    };
    auto epi = [&](f32x16(&acc)[4], int m, int h, int tok0) __attribute__((always_inline)) {
#pragma unroll
      for (int q = 0; q < 4; ++q)
#pragma unroll
        for (int ig = 0; ig < 4; ++ig) {
          const f32x4 bb = *(const f32x4*)(cb + 32 * q + 8 * ig + 4 * h);
          acc[q][4 * ig] = siluf(acc[q][4 * ig] + bb.x);
          acc[q][4 * ig + 1] = siluf(acc[q][4 * ig + 1] + bb.y);
          acc[q][4 * ig + 2] = siluf(acc[q][4 * ig + 2] + bb.z);
          acc[q][4 * ig + 3] = siluf(acc[q][4 * ig + 3] + bb.w);
        }
      store_plain(acc, hid + (size_t)m * 256 + nt * 128, h);
    };
    gemm_block<false>(raw, rowp, 256, wt, 4096, mt * 256, nt * 128, smem, epi);
  }
}
DI void phase_mlp2(const Params& p, int layer, char* smem) {
  const int G = gridDim.x, bid = blockIdx.x;
  const int e = layer >> 1;
  char* ws = ows(p.ws);
  const float* c64 = (const float*)(ws + OFF_COS64);
  const float* s64 = (const float*)(ws + OFF_SIN64);
  for (int it = bid; it < 16; it += G) {
    const int kv = it >> 3, mt = it & 7;
    const u16* hid = (const u16*)(ws + E_HID) + (size_t)kv * 2048 * 256;
    const u16* wt = (const u16*)(ws + OFF_W2T) + (size_t)kv * 128 * 256;
    auto rowp = [&](int m) __attribute__((always_inline)) { return (u32)m * 256u; };
    auto epi = [&](f32x16(&acc)[4], int m, int h, int tok0) __attribute__((always_inline)) {
      int b, c, g;
      cmp_rowdec(m, b, c, g);
      if (m < 2044) {
        if (kv == 0) {
          norm_rope128<false>(acc, (const float*)(smem + GAIN_OFF), c64, s64, 16 * c + 31, h);
          store_plain(acc, (u16*)(ws + E_KC) + ((size_t)(b * 512 + c)) * 256 + g * 128, h);
        } else {
          store_vt(acc, (u16*)(ws + E_VCT) + (size_t)((b * 2 + g) * 128) * 512 + c, 512, h);
        }
      }
    };
    gemm_block<true>(hid, rowp, 128, wt, 256, mt * 256, 0, smem, epi, kv == 0 ? p.nsa_qk_gain + (e * 4 + 1) * 128 : nullptr);
  }
}

struct FS {
  f32x16 O[4];
  float m, l;
};
constexpr int KS_LD = 136, VS_LD = 68;
constexpr int KS_BYTES = 64 * KS_LD * 2, VS_BYTES = 128 * VS_LD * 2;

struct TileRegs {
  u32x4 k[4], v[4];
};
DI void tile_gload_k(TileRegs& tr, const u16* __restrict__ kb, int ldk) {
  const int tid = otid();
#pragma unroll
  for (int i = 0; i < 4; ++i) {
    const int c = tid + 256 * i;
    tr.k[i] = *(const u32x4*)(kb + (size_t)(c >> 4) * ldk + (c & 15) * 8);
  }
}
DI void tile_gload_v(TileRegs& tr, const u16* __restrict__ vb, int ldv) {
  const int tid = otid();
#pragma unroll
  for (int i = 0; i < 4; ++i) {
    const int c = tid + 256 * i;
    tr.v[i] = *(const u32x4*)(vb + (size_t)(c >> 3) * ldv + (c & 7) * 8);
  }
}
DI void tile_sstore_k(const TileRegs& tr, u16* Ks) {
  const int tid = otid();
#pragma unroll
  for (int i = 0; i < 4; ++i) {
    const int c = tid + 256 * i;
    *(u32x4*)(Ks + (c >> 4) * KS_LD + (c & 15) * 8) = tr.k[i];
  }
}
DI void tile_sstore_v(const TileRegs& tr, u16* Vs) {
  const int tid = otid();
#pragma unroll
  for (int i = 0; i < 4; ++i) {
    const int c = tid + 256 * i;
    u32x2* d = (u32x2*)(Vs + (c >> 3) * VS_LD + (c & 7) * 8);
    d[0] = mku2(tr.v[i].x, tr.v[i].y);
    d[1] = mku2(tr.v[i].z, tr.v[i].w);
  }
}

template <int NS>
DI void qk_tile(const u16* Ks, int kcol0, const bf16x8 (&qf)[NS], f32x16 (&S)[2], int r, int h) {
#pragma unroll
  for (int kt = 0; kt < 2; ++kt) {
    zero16(S[kt]);
#pragma unroll
    for (int s = 0; s < NS; ++s) {
      const bf16x8 a = *(const bf16x8*)(Ks + (32 * kt + r) * KS_LD + kcol0 + 16 * s + 8 * h);
      S[kt] = MFMA32(a, qf[s], S[kt]);
    }
  }
}
DI void pv_tile(const u16* Vs, const f32x16 (&P)[2], f32x16 (&O)[4], int r, int h) {
#pragma unroll
  for (int kt = 0; kt < 2; ++kt)
#pragma unroll
    for (int s = 0; s < 2; ++s) {
      u32x4 pu;
      pu.x = pk2(P[kt][8 * s + 0], P[kt][8 * s + 1]);
      pu.y = pk2(P[kt][8 * s + 2], P[kt][8 * s + 3]);
      pu.z = pk2(P[kt][8 * s + 4], P[kt][8 * s + 5]);
      pu.w = pk2(P[kt][8 * s + 6], P[kt][8 * s + 7]);
      const bf16x8 pf = __builtin_bit_cast(bf16x8, pu);
#pragma unroll
      for (int dt = 0; dt < 4; ++dt) {
        const u16* vp = Vs + (32 * dt + r) * VS_LD + 32 * kt + 16 * s + 4 * h;
        const u32x2 lo = *(const u32x2*)(vp);
        const u32x2 hi = *(const u32x2*)(vp + 8);
        const u32x4 vu = mku4(lo.x, lo.y, hi.x, hi.y);
        O[dt] = MFMA32(__builtin_bit_cast(bf16x8, vu), pf, O[dt]);
      }
    }
}

DI bool tile_on(u32 e0, u32 e1, u32 e2, u32 e3, int j) {
  const u32 wsel = j < 32 ? e0 : (j < 64 ? e1 : (j < 96 ? e2 : e3));
  return (wsel >> (j & 31)) & 1u;
}
DI int tile_next(u32 e0, u32 e1, u32 e2, u32 e3, int j, int j_hi) {
  while (j <= j_hi && !tile_on(e0, e1, e2, e3, j)) ++j;
  return j;
}

constexpr int TILE_BYTES = KS_BYTES + VS_BYTES;
constexpr int SELM_OFF = 2 * TILE_BYTES + 64;

template <class Mask>
DI float softmax_tile(f32x16 (&S)[2], FS& st, float scale2, Mask& mk, int j, int h) {
  mk.begin(j);
  const bool need = Mask::ALWAYS ? true : (__ballot(mk.needs(j)) != 0ull);
  if (need) {
#pragma unroll
    for (int kt = 0; kt < 2; ++kt)
#pragma unroll
      for (int i = 0; i < 16; ++i) {
        const bool ok = mk.ok(kt, i, j * 64 + 32 * kt + crow(i, h));
        S[kt][i] = ok ? S[kt][i] : -INFINITY;
      }
  }
  float mraw = -INFINITY;
#pragma unroll
  for (int kt = 0; kt < 2; ++kt)
#pragma unroll
    for (int i = 0; i < 16; ++i) mraw = fmaxf(mraw, S[kt][i]);
  mraw = fmaxf(mraw, __shfl_xor(mraw, 32));
  const float mold = st.m;
  const float mnew = mraw * scale2;
  float mx = mold;
  if (__ballot(mnew > mold + 8.f) != 0ull) mx = fmaxf(mold, mnew);
  const float alpha = __builtin_amdgcn_exp2f(mold - mx);
  float rs = 0.f;
#pragma unroll
  for (int kt = 0; kt < 2; ++kt)
#pragma unroll
    for (int i = 0; i < 16; ++i) {
      const float pv = __builtin_amdgcn_exp2f(__builtin_fmaf(S[kt][i], scale2, -mx));
      S[kt][i] = pv;
      rs += pv;
    }
  st.l = st.l * alpha + rs;
  st.m = mx;
  return alpha;
}

template <int NS, class Mask>
DI void flash_tiles(FS& st, const bf16x8 (&qf)[NS], const u16* __restrict__ kbase, int ldk, int kcol0,
                    const u16* __restrict__ vtbase, int ldv, int j_lo, int j_hi, u32 e0, u32 e1, u32 e2, u32 e3,
                    float scale2, Mask& mk, char* smem) {
  const int lane = otid() & 63, r = lane & 31, h = lane >> 5;
  int j = tile_next(e0, e1, e2, e3, j_lo, j_hi);
  if (j > j_hi) return;
  TileRegs tr;
  tile_gload_k(tr, kbase + (size_t)j * 64 * ldk, ldk);
  tile_gload_v(tr, vtbase + j * 64, ldv);
  __syncthreads();
  tile_sstore_k(tr, (u16*)smem);
  tile_sstore_v(tr, (u16*)(smem + KS_BYTES));
  int jn = tile_next(e0, e1, e2, e3, j + 1, j_hi);
  if (jn <= j_hi) {
    tile_gload_k(tr, kbase + (size_t)jn * 64 * ldk, ldk);
    tile_gload_v(tr, vtbase + jn * 64, ldv);
  }
  int cur = 0;
  while (true) {
    __syncthreads();
    int jnn = j_hi + 1;
    if (jn <= j_hi) {
      char* nb = smem + (cur ^ 1) * TILE_BYTES;
      tile_sstore_k(tr, (u16*)nb);
      tile_sstore_v(tr, (u16*)(nb + KS_BYTES));
      jnn = tile_next(e0, e1, e2, e3, jn + 1, j_hi);
      if (jnn <= j_hi) {
        tile_gload_k(tr, kbase + (size_t)jnn * 64 * ldk, ldk);
        tile_gload_v(tr, vtbase + jnn * 64, ldv);
      }
    }
    const u16* Ks = (const u16*)(smem + cur * TILE_BYTES);
    const u16* Vs = (const u16*)(smem + cur * TILE_BYTES + KS_BYTES);
    f32x16 S[2];
    __builtin_amdgcn_s_setprio(1);
    qk_tile<NS>(Ks, kcol0, qf, S, r, h);
    __builtin_amdgcn_s_setprio(0);
    const float alpha = softmax_tile(S, st, scale2, mk, j, h);
    if (__ballot(alpha != 1.f) != 0ull) {
#pragma unroll
      for (int dt = 0; dt < 4; ++dt)
#pragma unroll
        for (int i = 0; i < 16; ++i) st.O[dt][i] *= alpha;
    }
    __builtin_amdgcn_s_setprio(1);
    pv_tile(Vs, S, st.O, r, h);
    __builtin_amdgcn_s_setprio(0);
    if (jn > j_hi) break;
    j = jn;
    jn = jnn;
    cur ^= 1;
  }
}

struct MaskCausal {
  static constexpr bool ALWAYS = false;
  int t;
  DI void begin(int) {}
  DI bool needs(int j) const { return 64 * j + 63 > t; }
  DI bool ok(int, int, int key) const { return key <= t; }
};
struct MaskWin {
  static constexpr bool ALWAYS = false;
  int t;
  DI void begin(int) {}
  DI bool needs(int j) const { return 64 * j + 63 > t || 64 * j <= t - 512; }
  DI bool ok(int, int, int key) const { return key <= t && key > t - 512; }
};
struct MaskCmp {
  static constexpr bool ALWAYS = false;
  int cmax;
  DI void begin(int) {}
  DI bool needs(int j) const { return 64 * j + 63 > cmax; }
  DI bool ok(int, int, int key) const { return key <= cmax; }
};
struct MaskNone {
  static constexpr bool ALWAYS = false;
  DI void begin(int) {}
  DI bool needs(int) const { return false; }
  DI bool ok(int, int, int) const { return true; }
};
struct MaskSel {
  static constexpr bool ALWAYS = false;
  int t;
  u32 b0, b1, b2, b3;
  bool on;
  DI void begin(int j) { on = tile_on(b0, b1, b2, b3, j); }
  DI bool needs(int j) const { return !on || 64 * j + 63 > t; }
  DI bool ok(int, int, int key) const { return on && key <= t; }
};
struct MaskDsa {
  static constexpr bool ALWAYS = true;
  const u64* base;
  int sh;
  u32 lo, hi;
  DI void begin(int j) {
    const u64 w = base[(size_t)j * SEQ];
    lo = (u32)w >> sh;
    hi = (u32)(w >> 32) >> sh;
  }
  DI bool needs(int) const { return true; }
  DI bool ok(int kt, int i, int) const { return (((kt ? hi : lo) >> ((i & 3) + 8 * (i >> 2))) & 1u) != 0u; }
};

template <int NS>
DI void load_q(bf16x8 (&qf)[NS], const u16* __restrict__ qrow, int h) {
#pragma unroll
  for (int s = 0; s < NS; ++s) qf[s] = *(const bf16x8*)(qrow + 16 * s + 8 * h);
}
DI void fs_init(FS& st) {
#pragma unroll
  for (int i = 0; i < 4; ++i) zero16(st.O[i]);
  st.m = -3.0e38f;
  st.l = 0.f;
}
DI float fs_invl(const FS& st) {
  const float lt = st.l + __shfl_xor(st.l, 32);
  return lt > 0.f ? 1.f / lt : 0.f;
}

template <bool ACCUM>
DI void store_gated(const f32x16 (&O)[4], float coef, const u16* __restrict__ zrow, u16* __restrict__ yrow, int h) {
#pragma unroll
  for (int hb = 0; hb < 2; ++hb) {
    u32x2 zz[8], yy[8];
#pragma unroll
    for (int k = 0; k < 8; ++k) {
      const int dt = 2 * hb + (k >> 2), ig = k & 3;
      const int d = 32 * dt + 8 * ig + 4 * h;
      zz[k] = *(const u32x2*)(zrow + d);
      if (ACCUM) yy[k] = *(const u32x2*)(yrow + d);
    }
#pragma unroll
    for (int k = 0; k < 8; ++k) {
      const int dt = 2 * hb + (k >> 2), ig = k & 3;
      const int d = 32 * dt + 8 * ig + 4 * h;
      const u32x2 z2 = zz[k];
      float v0 = coef * O[dt][4 * ig] * siluf(bflo(z2.x));
      float v1 = coef * O[dt][4 * ig + 1] * siluf(bfhi(z2.x));
      float v2 = coef * O[dt][4 * ig + 2] * siluf(bflo(z2.y));
      float v3 = coef * O[dt][4 * ig + 3] * siluf(bfhi(z2.y));
      if (ACCUM) {
        const u32x2 y2 = yy[k];
        v0 += bflo(y2.x);
        v1 += bfhi(y2.x);
        v2 += bflo(y2.y);
        v3 += bfhi(y2.y);
      }
      u32x2 o;
      o.x = pk2(v0, v1);
      o.y = pk2(v2, v3);
      *(u32x2*)(yrow + d) = o;
    }
    __builtin_amdgcn_sched_barrier(0);
  }
}

constexpr u32 ALLON = 0xffffffffu;

DI void item_diff(const Params& p, int layer, int id, char* smem) {
  char* ws = ows(p.ws);
  const int e = layer >> 1;
  const int qt = 127 - (id >> 3), b = (id >> 2) & 1, hd = id & 3;
  const int tid = otid(), lane = tid & 63, w = tid >> 6, r = lane & 31, h = lane >> 5;
  const int c = w >> 1;
  const int t = qt * 64 + 32 * (w & 1) + r;
  const size_t tok = (size_t)b * SEQ + t;
  bf16x8 qf[4];
  load_q<4>(qf, (const u16*)(ws + E_BQ) + tok * 512 + hd * 128 + c * 64, h);
  FS st;
  fs_init(st);
  MaskCausal mk{t};
  flash_tiles<4>(st, qf, (const u16*)(ws + E_BK) + (size_t)b * SEQ * 512 + hd * 128, 512, 64 * c,
                       (const u16*)(ws + E_BVT) + (size_t)((b * 4 + hd) * 128) * SEQ, SEQ, 0, qt, ALLON, ALLON, ALLON,
                       ALLON, 0.125f * LOG2E, mk, smem);
  const float il = fs_invl(st);
  float* ex = (float*)smem;
  __syncthreads();
  if (c == 1) {
#pragma unroll
    for (int dt = 0; dt < 4; ++dt)
#pragma unroll
      for (int i = 0; i < 16; ++i) ex[((w & 1) * 64 + dt * 16 + i) * 64 + lane] = st.O[dt][i] * il;
  }
  __syncthreads();
  if (c == 0) {
    const float lambda_init = 0.8f - 0.6f * expf(-0.3f * (float)layer);
    const float lam = ((const float*)(ws + OFF_MISC))[e] + lambda_init;
    float ss = 0.f;
#pragma unroll
    for (int dt = 0; dt < 4; ++dt)
#pragma unroll
      for (int i = 0; i < 16; ++i) {
        const float a = st.O[dt][i] * il - lam * ex[((w & 1) * 64 + dt * 16 + i) * 64 + lane];
        st.O[dt][i] = a;
        ss += a * a;
      }
    ss += __shfl_xor(ss, 32);
    const float rinv = rsqrtf(ss * (1.f / 128.f) + EPS) * (1.f - lambda_init);
    const float* sg = p.diff_subln_gain + e * 128;
#pragma unroll
    for (int dt = 0; dt < 4; ++dt)
#pragma unroll
      for (int ig = 0; ig < 4; ++ig) {
        const f32x4 g = *(const f32x4*)(sg + 32 * dt + 8 * ig + 4 * h);
        st.O[dt][4 * ig] *= g.x;
        st.O[dt][4 * ig + 1] *= g.y;
        st.O[dt][4 * ig + 2] *= g.z;
        st.O[dt][4 * ig + 3] *= g.w;
      }
    store_gated<false>(st.O, rinv, (const u16*)(ws + OFF_Z) + tok * DM + 1024 + hd * 128,
                       (u16*)(ws + OFF_HY) + tok * DM + 1024 + hd * 128, h);
  }
}

DI void item_win(const Params& p, int id, char* smem) {
  char* ws = ows(p.ws);
  const int qt = id >> 2, b = (id >> 1) & 1, g = id & 1;
  const int tid = otid(), lane = tid & 63, w = tid >> 6, r = lane & 31, h = lane >> 5;
  const int t = qt * 32 + 8 * w + (r & 7), hq = 4 * g + (r >> 3);
  const size_t tok = (size_t)b * SEQ + t;
  bf16x8 qf[8];
  load_q<8>(qf, (const u16*)(ws + E_QA) + tok * 1024 + hq * 128, h);
  FS st;
  fs_init(st);
  MaskWin mk{t};
  int lo = qt * 32 - 511;
  lo = lo < 0 ? 0 : lo >> 6;
  flash_tiles<8>(st, qf, (const u16*)(ws + E_KW) + (size_t)b * SEQ * 256 + g * 128, 256, 0,
                       (const u16*)(ws + E_VWT) + (size_t)((b * 2 + g) * 128) * SEQ, SEQ, lo, (qt * 32 + 31) >> 6, ALLON,
                       ALLON, ALLON, ALLON, 0.08838834764831845f * LOG2E, mk, smem);
  const float il = fs_invl(st);
  const float gate = sigmf(((const float*)(ws + E_AG))[tok * 32 + hq * 3 + 2]);
  store_gated<false>(st.O, il * gate, (const u16*)(ws + OFF_Z) + tok * DM + hq * 128, (u16*)(ws + OFF_HY) + tok * DM + hq * 128,
                     h);
}

DI void item_sel(const Params& p, int id, char* smem) {
  char* ws = ows(p.ws);
  const int qt = 255 - (id >> 2), b = (id >> 1) & 1, g = id & 1;
  const int tid = otid(), lane = tid & 63, w = tid >> 6, r = lane & 31, h = lane >> 5;
  const int t = qt * 32 + 8 * w + (r & 7), hq = 4 * g + (r >> 3);
  const size_t tok = (size_t)b * SEQ + t;
  __syncthreads();
  const u32x4 sm4 = *(const u32x4*)((const u32*)(smem + SELM_OFF) + (8 * w + (r & 7)) * 4);
  u32 u0 = sm4.x, u1 = sm4.y, u2 = sm4.z, u3 = sm4.w;
#pragma unroll
  for (int o = 1; o <= 4; o <<= 1) {
    u0 |= __shfl_xor(u0, o);
    u1 |= __shfl_xor(u1, o);
    u2 |= __shfl_xor(u2, o);
    u3 |= __shfl_xor(u3, o);
  }
  u32* us = (u32*)(smem + 2 * TILE_BYTES);
  __syncthreads();
  if (lane == 0) {
    us[w * 4 + 0] = u0;
    us[w * 4 + 1] = u1;
    us[w * 4 + 2] = u2;
    us[w * 4 + 3] = u3;
  }
  __syncthreads();
  u0 = us[0] | us[4] | us[8] | us[12];
  u1 = us[1] | us[5] | us[9] | us[13];
  u2 = us[2] | us[6] | us[10] | us[14];
  u3 = us[3] | us[7] | us[11] | us[15];
  bf16x8 qf[8];
  load_q<8>(qf, (const u16*)(ws + E_QA) + tok * 1024 + hq * 128, h);
  FS st;
  fs_init(st);
  MaskSel mk{t, sm4.x, sm4.y, sm4.z, sm4.w, false};
  flash_tiles<8>(st, qf, (const u16*)(ws + E_KS) + (size_t)b * SEQ * 256 + g * 128, 256, 0,
                       (const u16*)(ws + E_VST) + (size_t)((b * 2 + g) * 128) * SEQ, SEQ, 0, (qt * 32 + 31) >> 6, u0, u1, u2,
                       u3, 0.08838834764831845f * LOG2E, mk, smem);
  const float il = fs_invl(st);
  const float gate = sigmf(((const float*)(ws + E_AG))[tok * 32 + hq * 3 + 1]);
  store_gated<true>(st.O, il * gate, (const u16*)(ws + OFF_Z) + tok * DM + hq * 128, (u16*)(ws + OFF_HY) + tok * DM + hq * 128,
                    h);
}

DI void item_cmp(const Params& p, int id, char* smem) {
  char* ws = ows(p.ws);
  const int qt = 255 - (id >> 2), b = (id >> 1) & 1, g = id & 1;
  const int tid = otid(), lane = tid & 63, w = tid >> 6, r = lane & 31, h = lane >> 5;
  const int tl = 8 * w + (r & 7);
  const int t = qt * 32 + tl, hq = 4 * g + (r >> 3);
  const size_t tok = (size_t)b * SEQ + t;
  const float scale2 = 0.08838834764831845f * LOG2E;
  u16* Ks = (u16*)smem;
  u16* Vs = (u16*)(smem + KS_BYTES);
  float* imp = (float*)(smem + KS_BYTES + VS_BYTES);
  __syncthreads();
  for (int i = tid; i < 32 * 132; i += NTHREADS) imp[i] = 0.f;
  bf16x8 qf[8];
  load_q<8>(qf, (const u16*)(ws + E_QA) + tok * 1024 + hq * 128, h);
  FS st;
  fs_init(st);
  MaskCmp mk{t >= 31 ? ((t - 31) >> 4) : -1};
  const int j_hi = qt >> 5;
  const u16* kbase = (const u16*)(ws + E_KC) + (size_t)b * 512 * 256 + g * 128;
  const u16* vtbase = (const u16*)(ws + E_VCT) + (size_t)((b * 2 + g) * 128) * 512;
  for (int j = 0; j <= j_hi; ++j) {
    TileRegs tr;
    tile_gload_k(tr, kbase + (size_t)j * 64 * 256, 256);
    __syncthreads();
    tile_sstore_k(tr, Ks);
    __syncthreads();
    f32x16 S[2];
    qk_tile<8>(Ks, 0, qf, S, r, h);
    softmax_tile(S, st, scale2, mk, j, h);
  }
  const float il = fs_invl(st);
  const float mfin = st.m;
  for (int j = 0; j <= j_hi; ++j) {
    TileRegs tr;
    tile_gload_k(tr, kbase + (size_t)j * 64 * 256, 256);
    tile_gload_v(tr, vtbase + j * 64, 512);
    __syncthreads();
    tile_sstore_k(tr, Ks);
    tile_sstore_v(tr, Vs);
    __syncthreads();
    f32x16 S[2];
    qk_tile<8>(Ks, 0, qf, S, r, h);
#pragma unroll
    for (int kt = 0; kt < 2; ++kt) {
#pragma unroll
      for (int i = 0; i < 16; ++i) {
        const int key = j * 64 + 32 * kt + crow(i, h);
        S[kt][i] = key <= mk.cmax ? __builtin_amdgcn_exp2f(S[kt][i] * scale2 - mfin) * il : 0.f;
      }
#pragma unroll
      for (int ig = 0; ig < 4; ++ig) {
        float vm = S[kt][4 * ig] + S[kt][4 * ig + 1] + S[kt][4 * ig + 2] + 0.5f * S[kt][4 * ig + 3];
        float vn = 0.5f * S[kt][4 * ig + 3];
        vm += __shfl_xor(vm, 8);
        vn += __shfl_xor(vn, 8);
        vm += __shfl_xor(vm, 16);
        vn += __shfl_xor(vn, 16);
        if ((r >> 3) == 0) {
          const int jj = 16 * j + 8 * kt + 2 * ig + h;
          atomicAdd(&imp[tl * 132 + jj], vm);
          atomicAdd(&imp[tl * 132 + jj + 1], vn);
        }
      }
    }
    pv_tile(Vs, S, st.O, r, h);
  }
  const float gate = sigmf(((const float*)(ws + E_AG))[tok * 32 + hq * 3 + 0]);
  store_gated<true>(st.O, gate, (const u16*)(ws + OFF_Z) + tok * DM + hq * 128, (u16*)(ws + OFF_HY) + tok * DM + hq * 128, h);
  __syncthreads();
  for (int q = 0; q < 8; ++q) {
    const int tl2 = 8 * w + q;
    const int t2 = qt * 32 + tl2;
    const int cur = t2 >> 6;
    const int j0 = lane, j1 = lane + 64;
    float v0 = j0 > cur ? -1e30f : ((j0 == 0 || j0 >= cur - 1) ? 1e9f : imp[tl2 * 132 + j0]);
    float v1 = j1 > cur ? -1e30f : ((j1 >= cur - 1) ? 1e9f : imp[tl2 * 132 + j1]);
    u32 m0 = 0, m1 = 0, m2 = 0, m3 = 0;
    for (int rd = 0; rd < 16; ++rd) {
      float bv = v0;
      int bj = j0;
      if (v1 > v0) {
        bv = v1;
        bj = j1;
      }
#pragma unroll
      for (int o = 32; o >= 1; o >>= 1) {
        const float ov = __shfl_xor(bv, o);
        const int oj = __shfl_xor(bj, o);
        if (ov > bv || (ov == bv && oj < bj)) {
          bv = ov;
          bj = oj;
        }
      }
      const u32 bit = 1u << (bj & 31);
      if (bj < 32) m0 |= bit;
      else if (bj < 64) m1 |= bit;
      else if (bj < 96) m2 |= bit;
      else m3 |= bit;
      if (bj == j0) v0 = -3e38f;
      if (bj == j1) v1 = -3e38f;
    }
    const int nb = cur + 1;
    const u32 k0 = nb >= 32 ? ALLON : ((1u << nb) - 1u);
    const u32 k1 = nb >= 64 ? ALLON : (nb <= 32 ? 0u : ((1u << (nb - 32)) - 1u));
    const u32 k2 = nb >= 96 ? ALLON : (nb <= 64 ? 0u : ((1u << (nb - 64)) - 1u));
    const u32 k3 = nb >= 128 ? ALLON : (nb <= 96 ? 0u : ((1u << (nb - 96)) - 1u));
    if (lane == 0)
      *(u32x4*)((u32*)(smem + SELM_OFF) + tl2 * 4) = mku4(m0 & k0, m1 & k1, m2 & k2, m3 & k3);
  }
}

DI void item_mem(const Params& p, int layer, int id, char* smem) {
  char* ws = ows(p.ws);
  const int par = layer & 1;
  const int qt = id >> 3, b = (id >> 2) & 1, hm = id & 3;
  const int tid = otid(), lane = tid & 63, w = tid >> 6, r = lane & 31, h = lane >> 5;
  const int t = qt * 128 + 32 * w + r;
  const size_t tok = (size_t)b * SEQ + t;
  bf16x8 qf[8];
  load_q<8>(qf, (const u16*)(ws + (par ? O_MQ : E_MQ)) + tok * 512 + hm * 128, h);
  FS st;
  fs_init(st);
  MaskNone mk;
  flash_tiles<8>(st, qf, (const u16*)(ws + OFF_MEMK) + ((size_t)layer * 512 + b * 256) * 512 + hm * 128, 512, 0,
                       (const u16*)(ws + OFF_MEMVT) + (size_t)(((layer * 2 + b) * 4 + hm) * 128) * 256, 256, 0, 3, ALLON,
                       ALLON, ALLON, ALLON, 0.08838834764831845f * LOG2E, mk, smem);
  const float il = fs_invl(st);
  store_gated<false>(st.O, il, (const u16*)(ws + OFF_Z) + tok * DM + 1536 + hm * 128,
                     (u16*)(ws + OFF_HY) + tok * DM + 1536 + hm * 128, h);
}

DI void item_dsa(const Params& p, int id, char* smem) {
  char* ws = ows(p.ws);
  const int qt = 63 - id / 24, rem = id % 24, b = rem / 12, hd = rem % 12, g = hd / 3;
  const int tid = otid(), lane = tid & 63, w = tid >> 6, r = lane & 31, h = lane >> 5;
  const int t = qt * 128 + 32 * w + r;
  const size_t tok = (size_t)b * SEQ + t;
  bf16x8 qf[8];
  load_q<8>(qf, (const u16*)(ws + O_CQ) + tok * 1536 + hd * 128, h);
  FS st;
  fs_init(st);
  MaskDsa mk{(const u64*)(ws + O_DMASK) + (size_t)b * 128 * SEQ + t, 4 * h, 0u, 0u};
  flash_tiles<8>(st, qf, (const u16*)(ws + O_CK) + (size_t)b * SEQ * 512 + g * 128, 512, 0,
                       (const u16*)(ws + O_CVT) + (size_t)((b * 4 + g) * 128) * SEQ, SEQ, 0, 2 * qt + 1, ALLON, ALLON, ALLON,
                       ALLON, 0.08838834764831845f * LOG2E, mk, smem);
  const float il = fs_invl(st);
  store_gated<false>(st.O, il, (const u16*)(ws + OFF_Z) + tok * DM + hd * 128, (u16*)(ws + OFF_HY) + tok * DM + hd * 128, h);
}

DI size_t sc_row(int b, int t) {
  const int q = t >> 7;
  return (size_t)b * SC_PER_B + (size_t)16384 * (q * (q + 1) / 2) + (size_t)(t & 127) * (128 * (q + 1));
}
constexpr int QS_LD = 1032;
DI void item_idx(const Params& p, int b, int qt32, int ch, char* smem) {
  char* ws = ows(p.ws);
  u16* Qs = (u16*)smem;
  float* wsm = (float*)(smem + 32 * QS_LD * 2);
  const int tid = otid(), lane = tid & 63, w = tid >> 6, r = lane & 31, h = lane >> 5;
  const int q0 = qt32 * 32;
  const int Lq = 128 * ((q0 >> 7) + 1);
  __syncthreads();
  {
    const u16* iq = (const u16*)(ws + O_IQ) + ((size_t)b * SEQ + q0) * 1024;
#pragma unroll
    for (int i = 0; i < 16; ++i) {
      const int c = tid + 256 * i;
      *(u32x4*)(Qs + (c >> 7) * QS_LD + (c & 127) * 8) = *(const u32x4*)(iq + (size_t)(c >> 7) * 1024 + (c & 127) * 8);
    }
    const float* iw = (const float*)(ws + O_IW) + ((size_t)b * SEQ + q0) * 16;
    for (int i = tid; i < 512; i += NTHREADS) wsm[i] = iw[i];
  }
  __syncthreads();
  const int key0 = ch * 512 + 128 * w;
  if (key0 >= Lq) return;
  const u16* ik = (const u16*)(ws + O_IK) + ((size_t)b * SEQ + key0) * 64;
  bf16x8 kf[4][4];
#pragma unroll
  for (int sub = 0; sub < 4; ++sub)
#pragma unroll
    for (int s = 0; s < 4; ++s) kf[sub][s] = *(const bf16x8*)(ik + (size_t)(32 * sub + r) * 64 + 16 * s + 8 * h);
  f32x16 acc[4];
#pragma unroll
  for (int i = 0; i < 4; ++i) zero16(acc[i]);
#pragma unroll 1
  for (int hh = 0; hh < 16; ++hh) {
    const float wv = wsm[r * 16 + hh];
    bf16x8 qf[4];
#pragma unroll
    for (int s = 0; s < 4; ++s) qf[s] = *(const bf16x8*)(Qs + r * QS_LD + hh * 64 + 16 * s + 8 * h);
#pragma unroll
    for (int sub = 0; sub < 4; ++sub) {
      f32x16 sx;
      zero16(sx);
      __builtin_amdgcn_s_setprio(1);
#pragma unroll
      for (int s = 0; s < 4; ++s) sx = MFMA32(kf[sub][s], qf[s], sx);
      __builtin_amdgcn_s_setprio(0);
#pragma unroll
      for (int i = 0; i < 16; ++i) acc[sub][i] += wv * fmaxf(sx[i], 0.f);
    }
  }
  const int t = q0 + r;
  u16* srow = (u16*)(ws + O_SC) + sc_row(b, t) + key0;
#pragma unroll
  for (int sub = 0; sub < 4; ++sub)
#pragma unroll
    for (int ig = 0; ig < 4; ++ig) {
      u16 hv[4];
#pragma unroll
      for (int q = 0; q < 4; ++q) {
        const _Float16 f = (_Float16)acc[sub][4 * ig + q];
        hv[q] = __builtin_bit_cast(u16, f);
      }
      u32x2 o;
      o.x = (u32)hv[0] | ((u32)hv[1] << 16);
      o.y = (u32)hv[2] | ((u32)hv[3] << 16);
      *(u32x2*)(srow + 32 * sub + 8 * ig + 4 * h) = o;
    }
}
DI void phase_idx(const Params& p, char* smem) {
  const int G = gridDim.x;
  for (int it = blockIdx.x; it < 2 * 2176; it += G) {
    const int b = it & 1;
    const int idx = it >> 1;
    int q4 = 0;
    while (q4 < 15 && 8 * (q4 + 1) * (q4 + 2) <= idx) ++q4;
    const int rem = idx - 8 * q4 * (q4 + 1);
    const int ch = rem >> 4, qt32 = q4 * 16 + (rem & 15);
    item_idx(p, b, qt32, ch, smem);
  }
}

DI u32 okey(u32 hbits) { return (hbits & 0x8000u) ? (~hbits & 0xffffu) : (hbits | 0x8000u); }
DI void wave_lds_sync() {
  __builtin_amdgcn_fence(__ATOMIC_SEQ_CST, "workgroup");
  __builtin_amdgcn_wave_barrier();
}
DI int find_bin(const u32* hist, int lane, u32 target, u32& above) {
  const u32 c0 = hist[4 * lane], c1 = hist[4 * lane + 1], c2 = hist[4 * lane + 2], c3 = hist[4 * lane + 3];
  const u32 tot = c0 + c1 + c2 + c3;
  u32 suf = tot;
#pragma unroll
  for (int o = 1; o < 64; o <<= 1) {
    const u32 v = __shfl_down(suf, o);
    if (lane + o < 64) suf += v;
  }
  const u64 bal = __ballot(suf >= target);
  const int sl = 63 - __builtin_clzll(bal | 1ull);
  u32 a = suf - tot;
  int bin;
  if (a + c3 >= target) bin = 3;
  else {
    a += c3;
    if (a + c2 >= target) bin = 2;
    else {
      a += c2;
      if (a + c1 >= target) bin = 1;
      else {
        a += c1;
        bin = 0;
      }
    }
  }
  const int resb = __shfl(4 * lane + bin, sl);
  above = __shfl(a, sl);
  return resb;
}
DI void phase_select(const Params& p, char* smem) {
  char* ws = ows(p.ws);
  const int tid = otid(), lane = tid & 63, w = tid >> 6;
  u32* hist = (u32*)smem + w * 256;
  const int gw = blockIdx.x * 4 + w, nw = gridDim.x * 4;
  u64* dmask = (u64*)(ws + O_DMASK);
  for (int row = gw; row < NTOK; row += nw) {
    const int b = row & 1, t = SEQ - 1 - (row >> 1);
    const int L = t + 1;
    const u16* srow = (const u16*)(ws + O_SC) + sc_row(b, t);
    u32 T = 0, need = 0x7fffffffu;
    const bool all = L <= 256;
    if (!all) {
      const int nit = (L + 511) >> 9;
      wave_lds_sync();
#pragma unroll
      for (int i = 0; i < 4; ++i) hist[lane + 64 * i] = 0;
      wave_lds_sync();
      for (int it = 0; it < nit; ++it) {
        const int i0 = it * 512 + lane * 8;
        const u32x4 v = *(const u32x4*)(srow + i0);
        const u32 vv[4] = {v.x, v.y, v.z, v.w};
#pragma unroll
        for (int q = 0; q < 8; ++q) {
          const u32 k = okey((vv[q >> 1] >> (16 * (q & 1))) & 0xffffu);
          if (i0 + q <= t) atomicAdd(&hist[k >> 8], 1u);
        }
      }
      wave_lds_sync();
      u32 above1;
      const int b1 = find_bin(hist, lane, 256u, above1);
      wave_lds_sync();
#pragma unroll
      for (int i = 0; i < 4; ++i) hist[lane + 64 * i] = 0;
      wave_lds_sync();
      for (int it = 0; it < nit; ++it) {
        const int i0 = it * 512 + lane * 8;
        const u32x4 v = *(const u32x4*)(srow + i0);
        const u32 vv[4] = {v.x, v.y, v.z, v.w};
#pragma unroll
        for (int q = 0; q < 8; ++q) {
          const u32 k = okey((vv[q >> 1] >> (16 * (q & 1))) & 0xffffu);
          if (i0 + q <= t && (int)(k >> 8) == b1) atomicAdd(&hist[k & 255u], 1u);
        }
      }
      wave_lds_sync();
      u32 above2;
      const int b2 = find_bin(hist, lane, 256u - above1, above2);
      T = ((u32)b1 << 8) | (u32)b2;
      need = 256u - above1 - above2;
    }
    const int ktmax = 2 * (t >> 7) + 1;
    const int nit3 = (ktmax + 1 + 7) >> 3;
    u32 tie_base = 0;
    for (int it = 0; it < nit3; ++it) {
      const int i0 = it * 512 + lane * 8;
      const u32x4 v = *(const u32x4*)(srow + i0);
      const u32 vv[4] = {v.x, v.y, v.z, v.w};
      u32 kk[8];
      u32 tc = 0;
#pragma unroll
      for (int q = 0; q < 8; ++q) {
        kk[q] = okey((vv[q >> 1] >> (16 * (q & 1))) & 0xffffu);
        if (i0 + q <= t && kk[q] == T) ++tc;
      }
      u32 inc = tc;
#pragma unroll
      for (int o = 1; o < 64; o <<= 1) {
        const u32 x = __shfl_up(inc, o);
        if (lane >= o) inc += x;
      }
      u32 rank = tie_base + inc - tc;
      tie_base += __shfl(inc, 63);
      u32 byte = 0;
#pragma unroll
      for (int q = 0; q < 8; ++q) {
        const bool valid = i0 + q <= t;
        bool s = false;
        if (valid) {
          if (all || kk[q] > T) s = true;
          else if (kk[q] == T) {
            s = rank < need;
            ++rank;
          }
        }
        byte |= (s ? 1u : 0u) << q;
      }
      const int sh = 8 * (lane & 7);
      u32 wlo = sh < 32 ? (byte << sh) : 0u;
      u32 whi = sh >= 32 ? (byte << (sh - 32)) : 0u;
#pragma unroll
      for (int o = 1; o <= 4; o <<= 1) {
        wlo |= __shfl_xor(wlo, o);
        whi |= __shfl_xor(whi, o);
      }
      const int kt = it * 8 + (lane >> 3);
      if ((lane & 7) == 0 && kt <= ktmax) dmask[((size_t)b * 128 + kt) * SEQ + t] = ((u64)whi << 32) | (u64)wlo;
    }
  }
}


#define XB_TMO      128
#define XB_XCNT(j)  (256  + 64 * (j))
#define XB_XSUB(j)  (1280 + 64 * (j))
#define XB_XGEN(j)  (2304 + 64 * (j))
#define XB_TOP      3328
#define XB_TOPGEN   3392
#define XCD_BAR_WORDS 3456
#define XB_SPIN_CAP (1u << 22)
#define LAS __attribute__((address_space(3)))
DI unsigned xb_ld(unsigned* p) { return __hip_atomic_load(p, __ATOMIC_RELAXED, __HIP_MEMORY_SCOPE_AGENT); }
DI unsigned xb_add(unsigned* p, unsigned v) { return __hip_atomic_fetch_add(p, v, __ATOMIC_RELAXED, __HIP_MEMORY_SCOPE_AGENT); }
DI unsigned xb_xcc_id() { return (unsigned)__builtin_amdgcn_s_getreg((3 << 11) | 20) & 0xFu; }
#define XB_SPIN(cond, bar) do { unsigned _sp = 0; while (cond) { __builtin_amdgcn_s_sleep(1); \
    if ((++_sp & 255u) == 0u) { if (xb_ld(&(bar)[XB_TMO])) break; if (_sp > XB_SPIN_CAP) { atomicAdd(&(bar)[XB_TMO], 1u); break; } } } } while (0)
struct XcdBarrier {
  unsigned* bar;
  unsigned x;
  volatile LAS unsigned* st;
};
DI void xcd_barrier_complete(unsigned* bar, unsigned x, unsigned& nloc, unsigned& nx) {
  const unsigned G = gridDim.x * gridDim.y * gridDim.z;
  unsigned sum, cnt, mine, sp = 0u;
  for (;;) {
    sum = 0u; cnt = 0u; mine = 0u;
#pragma unroll 1
    for (unsigned j = 0; j < 16; ++j) { const unsigned c = xb_ld(&bar[XB_XCNT(j)]); sum += c; cnt += (c > 0u) ? 1u : 0u; mine = (j == x) ? c : mine; }
    if (sum == G) break;
    __builtin_amdgcn_s_sleep(1);
    if ((++sp & 255u) == 0u) { if (xb_ld(&bar[XB_TMO])) break; if (sp > XB_SPIN_CAP) { atomicAdd(&bar[XB_TMO], 1u); break; } }
  }
  nloc = mine > 0u ? mine : 1u; nx = cnt > 0u ? cnt : 1u;
}
DI void xcd_barrier(const XcdBarrier& b) {
  asm volatile("s_waitcnt vmcnt(0)" ::: "memory");
  __syncthreads();
  if (__builtin_amdgcn_workitem_id_x() == 0) {
    unsigned* bar = (unsigned*)ows((char*)b.bar);
    __builtin_amdgcn_s_waitcnt(0);
    unsigned nloc = b.st[0], nx = b.st[1];
    if (nloc == 0u) { xcd_barrier_complete(bar, b.x, nloc, nx); b.st[0] = nloc; b.st[1] = nx; }
    const unsigned old = xb_add(&bar[XB_XSUB(b.x)], 1u);
    const unsigned gen = old / nloc;
    if (old + 1u == (gen + 1u) * nloc) {
      __builtin_amdgcn_fence(__ATOMIC_RELEASE, "agent");
      asm volatile("s_waitcnt vmcnt(0)" ::: "memory");
      const unsigned og = xb_add(&bar[XB_TOP], 1u);
      const unsigned tg = og / nx;
      if (og + 1u == (tg + 1u) * nx) xb_add(&bar[XB_TOPGEN], 1u);
      else XB_SPIN(xb_ld(&bar[XB_TOPGEN]) == tg, bar);
      __builtin_amdgcn_fence(__ATOMIC_ACQUIRE, "agent");
      xb_add(&bar[XB_XGEN(b.x)], 1u);
      asm volatile("s_waitcnt vmcnt(0)" ::: "memory");
    } else {
      XB_SPIN(xb_ld(&bar[XB_XGEN(b.x)]) == gen, bar);
      __builtin_amdgcn_fence(__ATOMIC_ACQUIRE, "agent");
      asm volatile("s_waitcnt vmcnt(0)" ::: "memory");
    }
  }
  __syncthreads();
}

DI XcdInfo xcd_info(const XcdBarrier& b, int* s_tmp) {
  __syncthreads();
  if (__builtin_amdgcn_workitem_id_x() == 0) {
    int xi = 0;
    unsigned* bar = (unsigned*)ows((char*)b.bar);
#pragma unroll 1
    for (unsigned j = 0; j < 16; ++j) {
      const unsigned c = xb_ld(&bar[XB_XCNT(j)]);
      if (j < b.x && c > 0u) ++xi;
    }
    s_tmp[0] = xi;
  }
  __syncthreads();
  XcdInfo r;
  r.xi = s_tmp[0];
  r.nloc = (int)b.st[0];
  r.nx = (int)b.st[1];
  r.lrank = (int)b.st[2];
  return r;
}

DI void run_phase(const Params& p, int ph, char* smem, int* s_item, const XcdBarrier& xb) {
  int layer, lp;
  if (ph < 6) { layer = 0; lp = ph; }
  else if (ph < 12) { layer = 1; lp = ph - 6; }
  else if (ph < 18) { layer = 2; lp = ph - 12; }
  else { layer = 3; lp = ph - 18; }
  int* ctr = (int*)(ows(p.ws) + OFF_CTR) + layer * 8;
  if (!(layer & 1)) {
    switch (lp) {
      case 0: phase_prep(p, layer, smem); break;
      case 1: phase_proj(p, layer, smem, xcd_info(xb, s_item)); break;
      case 2: {
        mlp1_tiles(p, smem);
        int it;
        while ((it = next_item(ctr + 0, s_item)) < 2560) {
          if (it < 1024) item_diff(p, layer, it, smem);
          else if (it < 2048) item_win(p, it - 1024, smem);
          else item_mem(p, layer, it - 2048, smem);
        }
      } break;
      case 3: phase_mlp2(p, layer, smem); break;
      case 4: {
        int it;
        while ((it = next_item(ctr + 1, s_item)) < 1024) {
          item_cmp(p, it, smem);
          item_sel(p, it, smem);
        }
      } break;
      default: phase_outproj(p, layer, smem, xcd_info(xb, s_item)); break;
    }
  } else {
    switch (lp) {
      case 0: phase_prep(p, layer, smem); break;
      case 1: phase_proj(p, layer, smem, xcd_info(xb, s_item)); break;
      case 2: {
        phase_idx(p, smem);
        int it;
        while ((it = next_item(ctr + 0, s_item)) < 512) item_mem(p, layer, it, smem);
      } break;
      case 3: phase_select(p, smem); break;
      case 4: {
        int it;
        while ((it = next_item(ctr + 1, s_item)) < 1536) item_dsa(p, it, smem);
      } break;
      default: phase_outproj(p, layer, smem, xcd_info(xb, s_item)); break;
    }
  }
}

constexpr int SMEM_BYTES = 2 * TILE_BYTES + 64 + 512;
constexpr int N_PHASES = 24;

__global__ void __launch_bounds__(NTHREADS, 2) trunk_megakernel(Params p) {
  __shared__ __attribute__((aligned(16))) char smem[SMEM_BYTES];
  __shared__ int s_item;
  __shared__ u32x4 xb_words;
  cg::grid_group grid = cg::this_grid();
  XcdBarrier xb;
  xb.bar = (unsigned*)(p.ws + OFF_BAR);
  xb.x = xb_xcc_id();
  xb.st = (volatile LAS unsigned*)&xb_words;
  if (__builtin_amdgcn_workitem_id_x() == 0) {
    xb.st[0] = 0u;
    xb.st[1] = 0u;
  }
  __syncthreads();
  if (__builtin_amdgcn_workitem_id_x() == 0) xb.st[2] = xb_add(&xb.bar[XB_XCNT(xb.x)], 1u);
  if (p.ph_end < 0) grid.sync();
  if (p.ph_begin == 0) phase_prep0_extra(p, smem);
  for (int ph = p.ph_begin; ph < p.ph_end; ++ph) {
    run_phase(p, ph, smem, &s_item, xb);
    if (ph + 1 < p.ph_end) xcd_barrier(xb);
  }
}

extern "C" void kernel_launch(void* const* d_in, const int* in_sizes, int n_in, void* d_out, int out_size, void* d_ws,
                              size_t ws_size, hipStream_t stream) {
  static int grid_blocks = 0;
  if (!grid_blocks) {
    int dev = 0, cus = 0, per_cu = 0;
    (void)hipGetDevice(&dev);
    (void)hipDeviceGetAttribute(&cus, hipDeviceAttributeMultiprocessorCount, dev);
    (void)hipOccupancyMaxActiveBlocksPerMultiprocessor(&per_cu, trunk_megakernel, NTHREADS, 0);
    if (per_cu > 2) per_cu = 2;
    if (per_cu < 1) per_cu = 1;
    grid_blocks = cus * per_cu;
  }
  Params p;
  memset(&p, 0, sizeof(p));
  p.x = (const float*)d_in[0];
  p.mem = (const float*)d_in[1];
  p.norm_gain = (const float*)d_in[2];
  p.mem_norm_gain = (const float*)d_in[3];
  p.mem_w_kv = (const float*)d_in[4];
  p.mem_qk_gain = (const float*)d_in[5];
  p.w_out = (const float*)d_in[6];
  p.even_w_in = (const float*)d_in[7];
  p.nsa_qk_gain = (const float*)d_in[8];
  p.nsa_cmp_pos = (const float*)d_in[9];
  p.nsa_cmp_w1 = (const float*)d_in[10];
  p.nsa_cmp_w2 = (const float*)d_in[11];
  p.diff_qk_gain = (const float*)d_in[12];
  p.diff_lambda = (const float*)d_in[13];
  p.diff_subln_gain = (const float*)d_in[14];
  p.odd_w_in = (const float*)d_in[15];
  p.dsa_qk_gain = (const float*)d_in[16];
  p.out = (float*)d_out;
  p.ws = (char*)d_ws;
  p.ph_begin = 0;
  p.ph_end = N_PHASES;
  (void)hipMemsetAsync(d_ws, 0, 4096, stream);
  (void)hipMemsetAsync((char*)d_ws + OFF_BAR, 0, 16384, stream);
  void* args[] = {&p};
  hipError_t err = hipLaunchCooperativeKernel((void*)trunk_megakernel, dim3(grid_blocks), dim3(NTHREADS), args, 0, stream);
  if (err != hipSuccess) fprintf(stderr, "cooperative launch failed: %s (grid %d)\n", hipGetErrorString(err), grid_blocks);
}
```

```cpp
#include <hip/hip_runtime.h>
#include <hip/hip_cooperative_groups.h>
#include <stdint.h>
#include <stdio.h>
#include <string.h>
namespace cg = cooperative_groups;

#define DI __device__ __forceinline__
typedef unsigned short u16;
typedef unsigned int u32;
typedef unsigned long long u64;
typedef __attribute__((ext_vector_type(8))) short bf16x8;
typedef __attribute__((ext_vector_type(16))) float f32x16;
typedef __attribute__((ext_vector_type(2))) float f32x2;
typedef __attribute__((ext_vector_type(4))) float f32x4;
typedef __attribute__((ext_vector_type(4))) unsigned int u32x4;
typedef __attribute__((ext_vector_type(2))) unsigned int u32x2;
typedef __attribute__((ext_vector_type(2))) __bf16 bf16x2;
#define MFMA32(a, b, c) __builtin_amdgcn_mfma_f32_32x32x16_bf16((a), (b), (c), 0, 0, 0)

constexpr int NB = 2, SEQ = 8192, DM = 2048, NTOK = NB * SEQ;
constexpr int EVEN_IN = 6680, ODD_IN = 6224, EVEN_NT = 53, ODD_NT = 49;
constexpr float EPS = 1e-6f;
constexpr float LOG2E = 1.4426950408889634f;
constexpr int NTHREADS = 256;

constexpr size_t MiB = 1ull << 20;
constexpr size_t OFF_CTR = 0;
constexpr size_t OFF_MISC = 4096;
constexpr size_t OFF_COS64 = 8192;
constexpr size_t OFF_SIN64 = OFF_COS64 + 2 * MiB;
constexpr size_t OFF_COS32 = OFF_SIN64 + 2 * MiB;
constexpr size_t OFF_SIN32 = OFF_COS32 + 1 * MiB;
constexpr size_t OFF_MEMN = OFF_SIN32 + 1 * MiB;
constexpr size_t OFF_MEMK = OFF_MEMN + 2 * MiB;
constexpr size_t OFF_MEMVT = OFF_MEMK + 2 * MiB;
constexpr size_t OFF_WKVT = OFF_MEMVT + 2 * MiB;
constexpr size_t OFF_WTIN = OFF_WKVT + 16 * MiB;
constexpr size_t OFF_WTOUT = OFF_WTIN + 27 * MiB;
constexpr size_t OFF_W1T = OFF_WTOUT + 8 * MiB;
constexpr size_t OFF_W2T = OFF_W1T + 4 * MiB;
constexpr size_t OFF_CBIAS = OFF_W2T + 128 * 1024;
constexpr size_t OFF_CBPART = OFF_CBIAS + 4096;
constexpr size_t OFF_BAR = OFF_CBPART + 131072;
constexpr size_t OFF_HY = OFF_CBIAS + 4096 + 8192 + (MiB - 128 * 1024 - 4096 - 8192 - 8192);
constexpr size_t OFF_Z = OFF_HY + 64 * MiB;
constexpr size_t OFF_L = OFF_Z + 64 * MiB;
constexpr size_t E_QA = OFF_L;
constexpr size_t E_KCRAW = E_QA + 32 * MiB;
constexpr size_t E_VCRAW = E_KCRAW + 8 * MiB;
constexpr size_t E_KS = E_VCRAW + 8 * MiB;
constexpr size_t E_VST = E_KS + 8 * MiB;
constexpr size_t E_KW = E_VST + 8 * MiB;
constexpr size_t E_VWT = E_KW + 8 * MiB;
constexpr size_t E_AG = E_VWT + 8 * MiB;
constexpr size_t E_BQ = E_AG + 2 * MiB;
constexpr size_t E_BK = E_BQ + 16 * MiB;
constexpr size_t E_BVT = E_BK + 16 * MiB;
constexpr size_t E_MQ = E_BVT + 16 * MiB;
constexpr size_t E_KC = E_MQ + 16 * MiB;
constexpr size_t E_VCT = E_KC + MiB / 2;
constexpr size_t E_HID = E_VCT + MiB / 2;
constexpr size_t E_SELM = E_HID + 2 * MiB;
constexpr size_t E_END = E_SELM + MiB / 2;
constexpr size_t O_CQ = OFF_L;
constexpr size_t O_CK = O_CQ + 48 * MiB;
constexpr size_t O_CVT = O_CK + 16 * MiB;
constexpr size_t O_IQ = O_CVT + 16 * MiB;
constexpr size_t O_IK = O_IQ + 32 * MiB;
constexpr size_t O_IW = O_IK + 2 * MiB;
constexpr size_t O_MQ = O_IW + 1 * MiB;
constexpr size_t O_DMASK = O_MQ + 16 * MiB;
constexpr size_t O_SC = O_DMASK + 16 * MiB;
constexpr size_t SC_PER_B = 16384ull * (64 * 65 / 2);
constexpr size_t O_END = O_SC + 2 * SC_PER_B * 2;

struct Params {
  const float *x, *mem, *norm_gain, *mem_norm_gain, *mem_w_kv, *mem_qk_gain, *w_out, *even_w_in, *nsa_qk_gain,
      *nsa_cmp_pos, *nsa_cmp_w1, *nsa_cmp_w2, *diff_qk_gain, *diff_lambda, *diff_subln_gain, *odd_w_in, *dsa_qk_gain;
  float* out;
  char* ws;
  int ph_begin, ph_end;
};

DI u16 f2bf(float x) {
  u32 u = __float_as_uint(x);
  u += 0x7fffu + ((u >> 16) & 1u);
  return (u16)(u >> 16);
}
DI u32x4 mku4(u32 a, u32 b, u32 c, u32 d) { u32x4 r = {a, b, c, d}; return r; }
DI u32x2 mku2(u32 a, u32 b) { u32x2 r = {a, b}; return r; }
DI f32x4 mkf4(float a, float b, float c, float d) { f32x4 r = {a, b, c, d}; return r; }
DI float bf2f(u16 v) { return __uint_as_float(((u32)v) << 16); }
DI u32 pk2(float a, float b) {
  f32x2 v = {a, b};
  bf16x2 r = __builtin_convertvector(v, bf16x2);
  return __builtin_bit_cast(u32, r);
}
DI float bflo(u32 v) { return __uint_as_float(v << 16); }
DI float bfhi(u32 v) { return __uint_as_float(v & 0xffff0000u); }
DI float siluf(float v) { return v / (1.f + __expf(-v)); }
DI float sigmf(float v) { return 1.f / (1.f + __expf(-v)); }
DI int otid() {
  int t = __builtin_amdgcn_workitem_id_x();
  asm volatile("" : "+v"(t));
  return t;
}
DI char* ows(char* w) {
  u64 v = (u64)(uintptr_t)w;
  asm volatile("" : "+s"(v));
  return (char*)(__attribute__((address_space(1))) char*)v;
}
DI int crow(int i, int h) { return (i & 3) + 8 * (i >> 2) + 4 * h; }
DI void zero16(f32x16& a) {
#pragma unroll
  for (int i = 0; i < 16; ++i) a[i] = 0.f;
}

DI int next_item(int* ctr, int* s_item) {
  __syncthreads();
  if (otid() == 0) *s_item = atomicAdd(ctr, 1);
  __syncthreads();
  return *s_item;
}

DI void tt_load(f32x4 (&v)[8], const float* __restrict__ src, int lds, int col0, int nvalid, int k0) {
  const int tid = otid();
  const int n4 = (tid & 15) * 4;
#pragma unroll
  for (int i = 0; i < 8; ++i) {
    const int k = (tid >> 4) + 16 * i;
    v[i] = mkf4(0.f, 0.f, 0.f, 0.f);
    if (n4 < nvalid) v[i] = *(const f32x4*)(src + (size_t)(k0 + k) * lds + col0 + n4);
  }
}
DI void tt_store(const f32x4 (&v)[8], u16* __restrict__ dst, int K, int n0, int k0, float* sm) {
  const int tid = otid();
  __syncthreads();
  {
    const int n4 = (tid & 15) * 4;
#pragma unroll
    for (int i = 0; i < 8; ++i) {
      const int k = (tid >> 4) + 16 * i;
      sm[k * 65 + n4 + 0] = v[i].x;
      sm[k * 65 + n4 + 1] = v[i].y;
      sm[k * 65 + n4 + 2] = v[i].z;
      sm[k * 65 + n4 + 3] = v[i].w;
    }
  }
  __syncthreads();
  {
    const int n = tid >> 2, ks = (tid & 3) * 32;
    u32x4* d = (u32x4*)(dst + (size_t)(n0 + n) * K + k0 + ks);
#pragma unroll
    for (int q = 0; q < 4; ++q) {
      u32 o[4];
#pragma unroll
      for (int j = 0; j < 4; ++j)
        o[j] = pk2(sm[(ks + 8 * q + 2 * j) * 65 + n], sm[(ks + 8 * q + 2 * j + 1) * 65 + n]);
      d[q] = mku4(o[0], o[1], o[2], o[3]);
    }
  }
}
DI void transpose_tile(const float* __restrict__ src, int lds, int col0, int nvalid, u16* __restrict__ dst, int K,
                       int n0, int k0, float* sm) {
  f32x4 v[8];
  tt_load(v, src, lds, col0, nvalid, k0);
  tt_store(v, dst, K, n0, k0, sm);
}

DI void rmsnorm_row(const float* __restrict__ src, const float* __restrict__ gain, u16* __restrict__ dst) {
  const int lane = otid() & 63;
  f32x4 v[8];
  float ss = 0.f;
#pragma unroll
  for (int i = 0; i < 8; ++i) {
    v[i] = *(const f32x4*)(src + (i * 64 + lane) * 4);
    ss += v[i].x * v[i].x + v[i].y * v[i].y + v[i].z * v[i].z + v[i].w * v[i].w;
  }
#pragma unroll
  for (int o = 32; o >= 1; o >>= 1) ss += __shfl_xor(ss, o);
  const float rinv = rsqrtf(ss * (1.f / 2048.f) + EPS);
#pragma unroll
  for (int i = 0; i < 8; ++i) {
    const f32x4 g = *(const f32x4*)(gain + (i * 64 + lane) * 4);
    u32x2 o;
    o.x = pk2(v[i].x * rinv * g.x, v[i].y * rinv * g.y);
    o.y = pk2(v[i].z * rinv * g.z, v[i].w * rinv * g.w);
    *(u32x2*)(dst + (i * 64 + lane) * 4) = o;
  }
}

DI void rmsnorm_row2(const float* __restrict__ src0, const float* __restrict__ src1, const float* __restrict__ gain,
                     u16* __restrict__ dst0, u16* __restrict__ dst1) {
  const int lane = otid() & 63;
  f32x4 v[8], u[8];
#pragma unroll
  for (int i = 0; i < 8; ++i) {
    v[i] = *(const f32x4*)(src0 + (i * 64 + lane) * 4);
    u[i] = *(const f32x4*)(src1 + (i * 64 + lane) * 4);
  }
  float ss = 0.f, st = 0.f;
#pragma unroll
  for (int i = 0; i < 8; ++i) {
    ss += v[i].x * v[i].x + v[i].y * v[i].y + v[i].z * v[i].z + v[i].w * v[i].w;
    st += u[i].x * u[i].x + u[i].y * u[i].y + u[i].z * u[i].z + u[i].w * u[i].w;
  }
#pragma unroll
  for (int o = 32; o >= 1; o >>= 1) {
    ss += __shfl_xor(ss, o);
    st += __shfl_xor(st, o);
  }
  const float rv = rsqrtf(ss * (1.f / 2048.f) + EPS), ru = rsqrtf(st * (1.f / 2048.f) + EPS);
#pragma unroll
  for (int i = 0; i < 8; ++i) {
    const f32x4 g = *(const f32x4*)(gain + (i * 64 + lane) * 4);
    u32x2 o;
    o.x = pk2(v[i].x * rv * g.x, v[i].y * rv * g.y);
    o.y = pk2(v[i].z * rv * g.z, v[i].w * rv * g.w);
    *(u32x2*)(dst0 + (i * 64 + lane) * 4) = o;
    o.x = pk2(u[i].x * ru * g.x, u[i].y * ru * g.y);
    o.y = pk2(u[i].z * ru * g.z, u[i].w * ru * g.w);
    *(u32x2*)(dst1 + (i * 64 + lane) * 4) = o;
  }
}
DI int even_src(int nt, int& valid) {
  valid = (nt == 20) ? 24 : 128;
  return nt <= 20 ? 128 * nt : 2584 + 128 * (nt - 21);
}
DI int odd_src(int nt, int& valid) {
  valid = (nt == 28) ? 80 : 128;
  return nt <= 28 ? 128 * nt : 3664 + 128 * (nt - 29);
}

DI void phase_prep(const Params& p, int layer, char* smem) {
  const int tid = otid(), G = gridDim.x, bid = blockIdx.x;
  const int par = layer & 1, e = layer >> 1;
  char* ws = ows(p.ws);
  float* sm = (float*)smem;
  const int gw = bid * 4 + (tid >> 6), nw = G * 4;
  {
    const float* xin = layer == 0 ? p.x : p.out;
    u16* hy = (u16*)(ws + OFF_HY);
    for (int row = gw; row < NTOK; row += 2 * nw) {
      const int row1 = row + nw;
      if (row1 < NTOK)
        rmsnorm_row2(xin + (size_t)row * DM, xin + (size_t)row1 * DM, p.norm_gain + layer * DM, hy + (size_t)row * DM,
                     hy + (size_t)row1 * DM);
      else
        rmsnorm_row(xin + (size_t)row * DM, p.norm_gain + layer * DM, hy + (size_t)row * DM);
    }
  }
  {
    u16* wtin = (u16*)(ws + OFF_WTIN);
    const int ntl = par ? ODD_NT : EVEN_NT;
    const float* win = par ? p.odd_w_in + (size_t)e * DM * ODD_IN : p.even_w_in + (size_t)e * DM * EVEN_IN;
    const int ldw = par ? ODD_IN : EVEN_IN;
    const int ntiles = ntl * 2 * 16;
    auto issue = [&](int it, f32x4(&vv)[8]) __attribute__((always_inline)) {
      const int kt = it & 15, n64 = it >> 4;
      int valid;
      const int sb = par ? odd_src(n64 >> 1, valid) : even_src(n64 >> 1, valid);
      const int half = n64 & 1;
      int nv = valid - 64 * half;
      nv = nv < 0 ? 0 : (nv > 64 ? 64 : nv);
      tt_load(vv, win, ldw, sb + 64 * half, nv, kt * 128);
    };
    f32x4 va[8];
    int it = bid;
    if (it < ntiles) issue(it, va);
    while (it < ntiles) {
      const int itn = it + G;
      f32x4 vb[8];
      if (itn < ntiles) issue(itn, vb);
      tt_store(va, wtin, DM, (it >> 4) * 64, (it & 15) * 128, sm);
#pragma unroll
      for (int i = 0; i < 8; ++i) va[i] = vb[i];
      it = itn;
    }
    u16* wtout = (u16*)(ws + OFF_WTOUT);
    const float* wo = p.w_out + (size_t)layer * DM * DM;
    for (int it = bid; it < 32 * 16; it += G)
      transpose_tile(wo, DM, (it >> 4) * 64, 64, wtout, DM, (it >> 4) * 64, (it & 15) * 128, sm);
  }
  if (!par) {
    u16* w1t = (u16*)(ws + OFF_W1T);
    for (int it = bid; it < 2 * 4 * 32; it += G) {
      const int kv = it >> 7, n64 = (it >> 5) & 3, kt = it & 31;
      transpose_tile(p.nsa_cmp_w1 + ((size_t)(e * 2 + kv)) * 4096 * 256, 256, n64 * 64, 64,
                     w1t + (size_t)kv * 256 * 4096, 4096, n64 * 64, kt * 128, sm);
    }
    u16* w2t = (u16*)(ws + OFF_W2T);
    for (int it = bid; it < 2 * 2 * 2; it += G) {
      const int kv = it >> 2, n64 = (it >> 1) & 1, kt = it & 1;
      transpose_tile(p.nsa_cmp_w2 + ((size_t)(e * 2 + kv)) * 256 * 128, 128, n64 * 64, 64, w2t + (size_t)kv * 128 * 256,
                     256, n64 * 64, kt * 128, sm);
    }
    float* cbp = (float*)(ws + OFF_CBPART);
    for (int it = bid; it < 128; it += G) {
      const int kv = it >> 6, chk = it & 63;
      const float* pe = p.nsa_cmp_pos + (size_t)(e * 2 + kv) * 4096 + chk * 64;
      const float* w1 = p.nsa_cmp_w1 + ((size_t)(e * 2 + kv)) * 4096 * 256 + (size_t)chk * 64 * 256;
      float a = 0.f;
#pragma unroll 16
      for (int f = 0; f < 64; ++f) a += pe[f] * w1[(size_t)f * 256 + tid];
      cbp[it * 256 + tid] = a;
    }
    if (bid == G - 1 && tid == 0) {
      const float* lv = p.diff_lambda + (size_t)e * 4 * 64;
      float s0 = 0.f, s1 = 0.f;
      for (int i = 0; i < 64; ++i) {
        s0 += lv[i] * lv[64 + i];
        s1 += lv[128 + i] * lv[192 + i];
      }
      ((float*)(ws + OFF_MISC))[e] = expf(s0) - expf(s1);
    }
  }
}

DI void phase_prep0_extra(const Params& p, char* smem) {
  const int tid = otid(), G = gridDim.x, bid = blockIdx.x;
  char* ws = ows(p.ws);
  float* sm = (float*)smem;
  const int gw = bid * 4 + (tid >> 6), nw = G * 4;
    float* c64 = (float*)(ws + OFF_COS64);
    float* s64 = (float*)(ws + OFF_SIN64);
    float* c32 = (float*)(ws + OFF_COS32);
    float* s32 = (float*)(ws + OFF_SIN32);
    for (int idx = bid * NTHREADS + tid; idx < SEQ * 64; idx += G * NTHREADS) {
      const int t = idx >> 6, i = idx & 63;
      const float inv = powf(10000.f, -(float)i / 64.f);
      const float ang = (float)t * inv;
      c64[idx] = cosf(ang);
      s64[idx] = sinf(ang);
      if (i < 32) {
        const float inv2 = powf(10000.f, -(float)i / 32.f);
        const float a2 = (float)t * inv2;
        c32[t * 32 + i] = cosf(a2);
        s32[t * 32 + i] = sinf(a2);
      }
    }
    u16* memn = (u16*)(ws + OFF_MEMN);
    for (int row = gw; row < NB * 256; row += nw)
      rmsnorm_row(p.mem + (size_t)row * DM, p.mem_norm_gain, memn + (size_t)row * DM);
    u16* wkvt = (u16*)(ws + OFF_WKVT);
    for (int it = bid; it < 4 * 16 * 16; it += G) {
      const int li = it >> 8, n64 = (it >> 4) & 15, kt = it & 15;
      transpose_tile(p.mem_w_kv + (size_t)li * DM * 1024, 1024, n64 * 64, 64, wkvt + (size_t)li * 1024 * DM, DM, n64 * 64,
                     kt * 128, sm);
    }
}

constexpr int GAIN_OFF = (256 + 128) * 72 * 2;
template <bool USTRIDE, class RowF, class EpiF>
DI void gemm_block(const u16* __restrict__ abase, RowF rowoff, int ldk2, const u16* __restrict__ Wt, int K, int m0, int n0,
                   char* smem, EpiF epi, const float* __restrict__ gsrc = nullptr, int gmask = 127) {
  u16* As = (u16*)smem;
  u16* Ws = As + 256 * 72;
  const int tid = otid(), lane = tid & 63, w = tid >> 6, r = lane & 31, h = lane >> 5;
  if (gsrc) {
    __syncthreads();
    if (tid < 128) ((float*)(smem + GAIN_OFF))[tid] = gsrc[tid & gmask];
  }
  f32x16 acc[2][4];
#pragma unroll
  for (int g = 0; g < 2; ++g)
#pragma unroll
    for (int i = 0; i < 4; ++i) zero16(acc[g][i]);
  const int kc = (tid & 7) * 8;
  u32 ao[8];
  if (USTRIDE) {
    ao[0] = rowoff(m0 + (tid >> 3));
    const u32 st32 = rowoff(32) - rowoff(0);
#pragma unroll
    for (int i = 1; i < 8; ++i) ao[i] = ao[0] + st32 * i;
  } else {
#pragma unroll
    for (int i = 0; i < 8; ++i) ao[i] = rowoff(m0 + (tid >> 3) + 32 * i);
  }
  const u16* wp0 = Wt + (size_t)(n0 + (tid >> 3)) * K + kc;
  const size_t wstep = (size_t)32 * K;
  const int lo = (tid >> 3) * 72 + kc;
  u32x4 ra[8], rw[4];
  {
    const int off = (kc >> 7) * ldk2 + (kc & 127);
#pragma unroll
    for (int i = 0; i < 8; ++i) ra[i] = *(const u32x4*)(abase + ao[i] + off);
#pragma unroll
    for (int i = 0; i < 4; ++i) rw[i] = *(const u32x4*)(wp0 + wstep * i);
  }
  for (int k0 = 0; k0 < K; k0 += 64) {
    __syncthreads();
#pragma unroll
    for (int i = 0; i < 8; ++i) *(u32x4*)(As + lo + 32 * 72 * i) = ra[i];
#pragma unroll
    for (int i = 0; i < 4; ++i) *(u32x4*)(Ws + lo + 32 * 72 * i) = rw[i];
    __syncthreads();
    if (k0 + 64 < K) {
      const int k = k0 + 64 + kc;
      const int off = (k >> 7) * ldk2 + (k & 127);
#pragma unroll
      for (int i = 0; i < 8; ++i) ra[i] = *(const u32x4*)(abase + ao[i] + off);
#pragma unroll
      for (int i = 0; i < 4; ++i) rw[i] = *(const u32x4*)(wp0 + wstep * i + k0 + 64);
    }
    __builtin_amdgcn_s_setprio(1);
#pragma unroll
    for (int s = 0; s < 4; ++s) {
      const bf16x8 b0 = *(const bf16x8*)(As + (64 * w + r) * 72 + 16 * s + 8 * h);
      const bf16x8 b1 = *(const bf16x8*)(As + (64 * w + 32 + r) * 72 + 16 * s + 8 * h);
#pragma unroll
      for (int nt = 0; nt < 4; ++nt) {
        const bf16x8 a = *(const bf16x8*)(Ws + (32 * nt + r) * 72 + 16 * s + 8 * h);
        acc[0][nt] = MFMA32(a, b0, acc[0][nt]);
        acc[1][nt] = MFMA32(a, b1, acc[1][nt]);
      }
    }
    __builtin_amdgcn_s_setprio(0);
  }
  __syncthreads();
  const int tok0 = __builtin_amdgcn_readfirstlane(m0 + 64 * w);
  epi(acc[0], tok0 + r, h, tok0);
  epi(acc[1], tok0 + 32 + r, h, tok0 + 32);
}

DI void norm128(f32x16 (&acc)[4], const float* gain, int h) {
  float ss = 0.f;
#pragma unroll
  for (int nt = 0; nt < 4; ++nt)
#pragma unroll
    for (int i = 0; i < 16; ++i) ss += acc[nt][i] * acc[nt][i];
  ss += __shfl_xor(ss, 32);
  const float rinv = rsqrtf(ss * (1.f / 128.f) + EPS);
#pragma unroll
  for (int nt = 0; nt < 4; ++nt) {
#pragma unroll
    for (int ig = 0; ig < 4; ++ig) {
      const f32x4 g = *(const f32x4*)(gain + 32 * nt + 8 * ig + 4 * h);
      acc[nt][4 * ig + 0] *= rinv * g.x;
      acc[nt][4 * ig + 1] *= rinv * g.y;
      acc[nt][4 * ig + 2] *= rinv * g.z;
      acc[nt][4 * ig + 3] *= rinv * g.w;
      if (ig & 1) __builtin_amdgcn_sched_barrier(0);
    }
  }
}
DI void norm64(f32x16 (&acc)[4], const float* gain, int h) {
  float rinv[2];
#pragma unroll
  for (int pp = 0; pp < 2; ++pp) {
    float ss = 0.f;
#pragma unroll
    for (int q = 0; q < 2; ++q)
#pragma unroll
      for (int i = 0; i < 16; ++i) ss += acc[2 * pp + q][i] * acc[2 * pp + q][i];
    ss += __shfl_xor(ss, 32);
    rinv[pp] = rsqrtf(ss * (1.f / 64.f) + EPS);
  }
#pragma unroll
  for (int q = 0; q < 2; ++q) {
#pragma unroll
    for (int ig = 0; ig < 4; ++ig) {
      const f32x4 g = *(const f32x4*)(gain + 32 * q + 8 * ig + 4 * h);
#pragma unroll
      for (int pp = 0; pp < 2; ++pp) {
        acc[2 * pp + q][4 * ig + 0] *= rinv[pp] * g.x;
        acc[2 * pp + q][4 * ig + 1] *= rinv[pp] * g.y;
        acc[2 * pp + q][4 * ig + 2] *= rinv[pp] * g.z;
        acc[2 * pp + q][4 * ig + 3] *= rinv[pp] * g.w;
      }
    }
    __builtin_amdgcn_sched_barrier(0);
  }
}
struct RopeTab128 {
  f32x4 c[4], s[4];
};
DI void rope128_load(RopeTab128& tb, int nt, const float* __restrict__ c64, const float* __restrict__ s64, int t, int h) {
#pragma unroll
  for (int ig = 0; ig < 4; ++ig) {
    const int d1 = 32 * nt + 8 * ig + 4 * h;
    tb.c[ig] = *(const f32x4*)(c64 + t * 64 + d1);
    tb.s[ig] = *(const f32x4*)(s64 + t * 64 + d1);
  }
}
DI void rope128_apply(f32x16 (&acc)[4], int nt, const RopeTab128& tb) {
#pragma unroll
  for (int ig = 0; ig < 4; ++ig)
#pragma unroll
    for (int q = 0; q < 4; ++q) {
      const int i = 4 * ig + q;
      const float c = tb.c[ig][q], sn = tb.s[ig][q];
      const float x1 = acc[nt][i], x2 = acc[nt + 2][i];
      acc[nt][i] = x1 * c - x2 * sn;
      acc[nt + 2][i] = x2 * c + x1 * sn;
    }
}
template <bool EARLY = true>
DI void norm_rope128(f32x16 (&acc)[4], const float* gl, const float* __restrict__ c64, const float* __restrict__ s64, int t, int h) {
  if (EARLY) {
    RopeTab128 tb;
    rope128_load(tb, 0, c64, s64, t, h);
    norm128(acc, gl, h);
    rope128_apply(acc, 0, tb);
    __builtin_amdgcn_sched_barrier(0);
    rope128_load(tb, 1, c64, s64, t, h);
    rope128_apply(acc, 1, tb);
  } else {
    norm128(acc, gl, h);
    __builtin_amdgcn_sched_barrier(0);
#pragma unroll
    for (int nt = 0; nt < 2; ++nt)
#pragma unroll
      for (int hb = 0; hb < 2; ++hb) {
        f32x4 c[2], sn[2];
#pragma unroll
        for (int k = 0; k < 2; ++k) {
          const int d1 = 32 * nt + 8 * (2 * hb + k) + 4 * h;
          c[k] = *(const f32x4*)(c64 + t * 64 + d1);
          sn[k] = *(const f32x4*)(s64 + t * 64 + d1);
        }
#pragma unroll
        for (int k = 0; k < 2; ++k)
#pragma unroll
          for (int q = 0; q < 4; ++q) {
            const int i = 4 * (2 * hb + k) + q;
            const float x1 = acc[nt][i], x2 = acc[nt + 2][i];
            acc[nt][i] = x1 * c[k][q] - x2 * sn[k][q];
            acc[nt + 2][i] = x2 * c[k][q] + x1 * sn[k][q];
          }
        __builtin_amdgcn_sched_barrier(0);
      }
  }
}
struct RopeTab64 {
  f32x4 c[4], s[4];
};
DI void rope64_load(RopeTab64& tb, const float* __restrict__ c32, const float* __restrict__ s32, int t, int h) {
#pragma unroll
  for (int ig = 0; ig < 4; ++ig) {
    const int d1 = 8 * ig + 4 * h;
    tb.c[ig] = *(const f32x4*)(c32 + t * 32 + d1);
    tb.s[ig] = *(const f32x4*)(s32 + t * 32 + d1);
  }
}
DI void rope64_apply(f32x16 (&acc)[4], int pp, const RopeTab64& tb) {
#pragma unroll
  for (int ig = 0; ig < 4; ++ig)
#pragma unroll
    for (int q = 0; q < 4; ++q) {
      const int i = 4 * ig + q;
      const float c = tb.c[ig][q], sn = tb.s[ig][q];
      const float x1 = acc[2 * pp][i], x2 = acc[2 * pp + 1][i];
      acc[2 * pp][i] = x1 * c - x2 * sn;
      acc[2 * pp + 1][i] = x2 * c + x1 * sn;
    }
}
DI void store_plain(const f32x16 (&acc)[4], u16* __restrict__ rowbase, int h) {
#pragma unroll
  for (int nt = 0; nt < 4; ++nt)
#pragma unroll
    for (int ig = 0; ig < 4; ++ig) {
      u32x2 o;
      o.x = pk2(acc[nt][4 * ig], acc[nt][4 * ig + 1]);
      o.y = pk2(acc[nt][4 * ig + 2], acc[nt][4 * ig + 3]);
      *(u32x2*)(rowbase + 32 * nt + 8 * ig + 4 * h) = o;
    }
}
constexpr int WB_LD = 136;
DI void store_rows(const f32x16 (&acc)[4], u16* __restrict__ base0, int ld, char* smem, int h) {
  const int tid = otid(), lane = tid & 63, w = tid >> 6, r = lane & 31;
  u16* wb = (u16*)smem + w * (32 * WB_LD);
#pragma unroll
  for (int nt = 0; nt < 4; ++nt)
#pragma unroll
    for (int ig = 0; ig < 4; ++ig) {
      u32x2 o;
      o.x = pk2(acc[nt][4 * ig], acc[nt][4 * ig + 1]);
      o.y = pk2(acc[nt][4 * ig + 2], acc[nt][4 * ig + 3]);
      *(u32x2*)(wb + r * WB_LD + 32 * nt + 8 * ig + 4 * h) = o;
    }
  __builtin_amdgcn_fence(__ATOMIC_SEQ_CST, "workgroup");
  __builtin_amdgcn_wave_barrier();
#pragma unroll
  for (int it = 0; it < 8; ++it) {
    const int row = it * 4 + (lane >> 4), ch = lane & 15;
    const u32x4 v = *(const u32x4*)(wb + row * WB_LD + ch * 8);
    *(u32x4*)(base0 + (size_t)row * ld + ch * 8) = v;
    if (it & 1) __builtin_amdgcn_sched_barrier(0);
  }
  __builtin_amdgcn_fence(__ATOMIC_SEQ_CST, "workgroup");
  __builtin_amdgcn_wave_barrier();
}
DI void store_vt(const f32x16 (&acc)[4], u16* __restrict__ base, size_t ld, int h) {
#pragma unroll
  for (int nt = 0; nt < 4; ++nt)
#pragma unroll
    for (int i = 0; i < 16; ++i) base[(size_t)(32 * nt + crow(i, h)) * ld] = f2bf(acc[nt][i]);
}

struct XcdInfo {
  int xi, nx, lrank, nloc;
};
DI void phase_proj(const Params& p, int layer, char* smem, const XcdInfo xc) {
  const int G = gridDim.x, bid = blockIdx.x;
  const int par = layer & 1, e = layer >> 1;
  char* ws = ows(p.ws);
  const u16* hy = (const u16*)(ws + OFF_HY);
  const u16* wtin = (const u16*)(ws + OFF_WTIN);
  const float* c64 = (const float*)(ws + OFF_COS64);
  const float* s64 = (const float*)(ws + OFF_SIN64);
  const float* c32 = (const float*)(ws + OFF_COS32);
  const float* s32 = (const float*)(ws + OFF_SIN32);
  u16* zb = (u16*)(ws + OFF_Z);
  if (!par && bid == G - 1) {
    const int tid = otid();
    const float* cbp = (const float*)(ws + OFF_CBPART);
    float* cb = (float*)(ws + OFF_CBIAS);
#pragma unroll
    for (int kv = 0; kv < 2; ++kv) {
      float a = 0.f;
#pragma unroll 16
      for (int c = 0; c < 64; ++c) a += cbp[(kv * 64 + c) * 256 + tid];
      cb[kv * 256 + tid] = a;
    }
  }
  const int ntl = par ? ODD_NT : EVEN_NT;
  const int ntiles = ntl * 64;
  const int mcount = (64 - xc.xi + xc.nx - 1) / xc.nx;
  const int nslots = ((mcount + 1) >> 1) * 2 * ntl;
  (void)ntiles;
  for (int it = xc.lrank; it < nslots; it += xc.nloc) {
    const int grp = it / (2 * ntl), rem = it - grp * 2 * ntl;
    const int nt = rem >> 1, ml = 2 * grp + (rem & 1);
    if (ml >= mcount) continue;
    const int mt = xc.xi + ml * xc.nx;
    auto rowp = [&](int m) __attribute__((always_inline)) { return (u32)m * (u32)DM; };
    const float* gsrc = nullptr;
    if (!par) {
      if (nt < 8) gsrc = p.nsa_qk_gain + (e * 4 + 0) * 128;
      else if (nt >= 12 && nt < 14) gsrc = p.nsa_qk_gain + (e * 4 + 2) * 128;
      else if (nt >= 16 && nt < 18) gsrc = p.nsa_qk_gain + (e * 4 + 3) * 128;
      else if (nt >= 29 && nt < 33) gsrc = p.diff_qk_gain + (e * 2 + 0) * 64;
      else if (nt >= 33 && nt < 37) gsrc = p.diff_qk_gain + (e * 2 + 1) * 64;
      else if (nt >= 45 && nt < 49) gsrc = p.mem_qk_gain + (layer * 2 + 0) * 128;
    } else {
      if (nt < 12) gsrc = p.dsa_qk_gain + (e * 2 + 0) * 128;
      else if (nt < 16) gsrc = p.dsa_qk_gain + (e * 2 + 1) * 128;
      else if (nt >= 41 && nt < 45) gsrc = p.mem_qk_gain + (layer * 2 + 0) * 128;
    }
    const float* gl = (const float*)(smem + GAIN_OFF);
    auto epi = [&](f32x16(&acc)[4], int tok, int h, int tok0) __attribute__((always_inline)) {
      const int t = tok & (SEQ - 1), b = tok >> 13;
      char* ws = ows(p.ws);
      u16* zb = (u16*)(ws + OFF_Z);
      if (!par) {
        if (nt < 8) {
          norm_rope128<false>(acc, gl, c64, s64, t, h);
          store_rows(acc, (u16*)(ws + E_QA) + (size_t)tok0 * 1024 + 128 * nt, 1024, smem, h);
        } else if (nt < 20) {
          const int j = (nt - 8) >> 1, g = (nt - 8) & 1;
          if (j == 0) store_rows(acc, (u16*)(ws + E_KCRAW) + (size_t)tok0 * 256 + g * 128, 256, smem, h);
          else if (j == 1) store_rows(acc, (u16*)(ws + E_VCRAW) + (size_t)tok0 * 256 + g * 128, 256, smem, h);
          else if (j == 2) {
            norm_rope128<false>(acc, gl, c64, s64, t, h);
            store_rows(acc, (u16*)(ws + E_KS) + (size_t)tok0 * 256 + g * 128, 256, smem, h);
          } else if (j == 3) store_vt(acc, (u16*)(ws + E_VST) + (size_t)((b * 2 + g) * 128) * SEQ + t, SEQ, h);
          else if (j == 4) {
            norm_rope128<false>(acc, gl, c64, s64, t, h);
            store_rows(acc, (u16*)(ws + E_KW) + (size_t)tok0 * 256 + g * 128, 256, smem, h);
          } else store_vt(acc, (u16*)(ws + E_VWT) + (size_t)((b * 2 + g) * 128) * SEQ + t, SEQ, h);
        } else if (nt == 20) {
          float* ag = (float*)(ws + E_AG) + (size_t)tok * 32;
#pragma unroll
          for (int ig = 0; ig < 3; ++ig)
            *(f32x4*)(ag + 8 * ig + 4 * h) =
                mkf4(acc[0][4 * ig], acc[0][4 * ig + 1], acc[0][4 * ig + 2], acc[0][4 * ig + 3]);
        } else if (nt < 29) store_rows(acc, zb + (size_t)tok0 * DM + 128 * (nt - 21), DM, smem, h);
        else if (nt < 37) {
          const int isk = nt >= 33;
          RopeTab64 tb;
          rope64_load(tb, c32, s32, t, h);
          norm64(acc, gl, h);
          rope64_apply(acc, 0, tb);
          rope64_apply(acc, 1, tb);
          store_rows(acc, (u16*)(ws + (isk ? E_BK : E_BQ)) + (size_t)tok0 * 512 + 128 * (isk ? nt - 33 : nt - 29), 512, smem, h);
        } else if (nt < 41) store_vt(acc, (u16*)(ws + E_BVT) + (size_t)((b * 4 + (nt - 37)) * 128) * SEQ + t, SEQ, h);
        else if (nt < 45) store_rows(acc, zb + (size_t)tok0 * DM + 1024 + 128 * (nt - 41), DM, smem, h);
        else if (nt < 49) {
          norm128(acc, gl, h);
          store_rows(acc, (u16*)(ws + E_MQ) + (size_t)tok0 * 512 + 128 * (nt - 45), 512, smem, h);
        } else store_rows(acc, zb + (size_t)tok0 * DM + 1536 + 128 * (nt - 49), DM, smem, h);
      } else {
        if (nt < 12) {
          norm_rope128<false>(acc, gl, c64, s64, t, h);
          store_rows(acc, (u16*)(ws + O_CQ) + (size_t)tok0 * 1536 + 128 * nt, 1536, smem, h);
        } else if (nt < 16) {
          norm_rope128<false>(acc, gl, c64, s64, t, h);
          store_rows(acc, (u16*)(ws + O_CK) + (size_t)tok0 * 512 + 128 * (nt - 12), 512, smem, h);
        } else if (nt < 20) store_vt(acc, (u16*)(ws + O_CVT) + (size_t)((b * 4 + (nt - 16)) * 128) * SEQ + t, SEQ, h);
        else if (nt < 28) {
          RopeTab64 tb;
          rope64_load(tb, c32, s32, t, h);
          rope64_apply(acc, 0, tb);
          rope64_apply(acc, 1, tb);
          store_rows(acc, (u16*)(ws + O_IQ) + (size_t)tok0 * 1024 + 128 * (nt - 20), 1024, smem, h);
        } else if (nt == 28) {
          RopeTab64 tb;
          rope64_load(tb, c32, s32, t, h);
          rope64_apply(acc, 0, tb);
          u16* ik = (u16*)(ws + O_IK) + (size_t)tok * 64;
#pragma unroll
          for (int q = 0; q < 2; ++q)
#pragma unroll
            for (int ig = 0; ig < 4; ++ig) {
              u32x2 o;
              o.x = pk2(acc[q][4 * ig], acc[q][4 * ig + 1]);
              o.y = pk2(acc[q][4 * ig + 2], acc[q][4 * ig + 3]);
              *(u32x2*)(ik + 32 * q + 8 * ig + 4 * h) = o;
            }
          float* iw = (float*)(ws + O_IW) + (size_t)tok * 16;
#pragma unroll
          for (int ig = 0; ig < 2; ++ig)
            *(f32x4*)(iw + 8 * ig + 4 * h) = mkf4(acc[2][4 * ig] * 0.03125f, acc[2][4 * ig + 1] * 0.03125f,
                                                          acc[2][4 * ig + 2] * 0.03125f, acc[2][4 * ig + 3] * 0.03125f);
        } else if (nt < 41) store_rows(acc, zb + (size_t)tok0 * DM + 128 * (nt - 29), DM, smem, h);
        else if (nt < 45) {
          norm128(acc, gl, h);
          store_rows(acc, (u16*)(ws + O_MQ) + (size_t)tok0 * 512 + 128 * (nt - 41), 512, smem, h);
        } else store_rows(acc, zb + (size_t)tok0 * DM + 1536 + 128 * (nt - 45), DM, smem, h);
      }
    };
    gemm_block<true>(hy, rowp, 128, wtin, DM, mt * 256, nt * 128, smem, epi, gsrc, (!par && nt >= 29 && nt < 37) ? 63 : 127);
  }
  if (layer == 0) {
    const u16* memn = (const u16*)(ws + OFF_MEMN);
    for (int it = bid; it < 4 * 2 * 8; it += G) {
      const int li = it >> 4, mt = (it >> 3) & 1, nt = it & 7;
      const u16* wt = (const u16*)(ws + OFF_WKVT) + (size_t)li * 1024 * DM;
      auto rowp = [&](int m) __attribute__((always_inline)) { return (u32)m * (u32)DM; };
      auto epi = [&](f32x16(&acc)[4], int row, int h, int tok0) __attribute__((always_inline)) {
        const int b = row >> 8, slot = row & 255;
        if (nt < 4) {
          norm128(acc, (const float*)(smem + GAIN_OFF), h);
          store_plain(acc, (u16*)(ws + OFF_MEMK) + ((size_t)li * 512 + row) * 512 + nt * 128, h);
        } else {
          store_vt(acc, (u16*)(ws + OFF_MEMVT) + (size_t)(((li * 2 + b) * 4 + (nt - 4)) * 128) * 256 + slot, 256, h);
        }
      };
      gemm_block<true>(memn, rowp, 128, wt, DM, mt * 256, nt * 128, smem, epi, nt < 4 ? p.mem_qk_gain + (li * 2 + 1) * 128 : nullptr);
    }
  }
}

DI void phase_outproj(const Params& p, int layer, char* smem, const XcdInfo xc) {
  const int G = gridDim.x, bid = blockIdx.x;
  const u16* y = (const u16*)(ows(p.ws) + OFF_HY);
  const u16* wt = (const u16*)(ows(p.ws) + OFF_WTOUT);
  const float* xin = (const float*)ows((char*)(layer == 0 ? p.x : p.out));
  float* xo = (float*)ows((char*)p.out);
  const int mcount = (64 - xc.xi + xc.nx - 1) / xc.nx;
  const int nslots = ((mcount + 1) >> 1) * 2 * 16;
  for (int it = xc.lrank; it < nslots; it += xc.nloc) {
    const int grp = it >> 5, rem = it & 31;
    const int nt = rem >> 1, ml = 2 * grp + (rem & 1);
    if (ml >= mcount) continue;
    const int mt = xc.xi + ml * xc.nx;
    auto rowp = [&](int m) __attribute__((always_inline)) { return (u32)m * (u32)DM; };
    auto epi = [&](f32x16(&acc)[4], int tok, int h, int tok0) __attribute__((always_inline)) {
      const int tid = otid(), lane = tid & 63, w = tid >> 6, r = lane & 31;
      float* wb = (float*)smem + w * (32 * 132);
#pragma unroll
      for (int q = 0; q < 4; ++q)
#pragma unroll
        for (int ig = 0; ig < 4; ++ig)
          *(f32x4*)(wb + r * 132 + 32 * q + 8 * ig + 4 * h) =
              mkf4(acc[q][4 * ig], acc[q][4 * ig + 1], acc[q][4 * ig + 2], acc[q][4 * ig + 3]);
      __builtin_amdgcn_fence(__ATOMIC_SEQ_CST, "workgroup");
      __builtin_amdgcn_wave_barrier();
      const size_t o0 = (size_t)tok0 * DM + nt * 128 + (lane & 31) * 4;
#pragma unroll
      for (int hb = 0; hb < 4; ++hb) {
        f32x4 xv[4];
#pragma unroll
        for (int k = 0; k < 4; ++k) {
          const int row = (4 * hb + k) * 2 + (lane >> 5);
          xv[k] = *(const f32x4*)(xin + o0 + (size_t)row * DM);
        }
#pragma unroll
        for (int k = 0; k < 4; ++k) {
          const int row = (4 * hb + k) * 2 + (lane >> 5);
          const f32x4 a = *(const f32x4*)(wb + row * 132 + (lane & 31) * 4);
          *(f32x4*)(xo + o0 + (size_t)row * DM) = xv[k] + a;
        }
      }
      __builtin_amdgcn_fence(__ATOMIC_SEQ_CST, "workgroup");
      __builtin_amdgcn_wave_barrier();
    };
    gemm_block<true>(y, rowp, 128, wt, DM, mt * 256, nt * 128, smem, epi);
  }
}

DI void cmp_rowdec(int m, int& b, int& c, int& g) {
  const int mm = m < 2044 ? m : 0;
  b = mm / 1022;
  const int rem = mm - b * 1022;
  c = rem >> 1;
  g = rem & 1;
}
DI void mlp1_tiles(const Params& p, char* smem) {
  const int G = gridDim.x, bid = blockIdx.x;
  char* ws = ows(p.ws);
  for (int it = bid; it < 32; it += G) {
    const int kv = it >> 4, mt = (it >> 1) & 7, nt = it & 1;
    const u16* raw = (const u16*)(ws + (kv ? E_VCRAW : E_KCRAW));
    const u16* wt = (const u16*)(ws + OFF_W1T) + (size_t)kv * 256 * 4096;
    const float* cb = (const float*)(ws + OFF_CBIAS) + kv * 256 + nt * 128;
    u16* hid = (u16*)(ws + E_HID) + (size_t)kv * 2048 * 256;
    auto rowp = [&](int m) __attribute__((always_inline)) {
      int b, c, g;
      cmp_rowdec(m, b, c, g);
      return (u32)((b * SEQ + 16 * c) * 256 + g * 128);
    };
    auto epi = [&](f32x16(&acc)[4], int m, int h, int tok0) __attribute__((always_inline)) {
#pragma unroll
      for (int q = 0; q < 4; ++q)
#pragma unroll
        for (int ig = 0; ig < 4; ++ig) {
          const f32x4 bb = *(const f32x4*)(cb + 32 * q + 8 * ig + 4 * h);
          acc[q][4 * ig] = siluf(acc[q][4 * ig] + bb.x);
          acc[q][4 * ig + 1] = siluf(acc[q][4 * ig + 1] + bb.y);
          acc[q][4 * ig + 2] = siluf(acc[q][4 * ig + 2] + bb.z);
          acc[q][4 * ig + 3] = siluf(acc[q][4 * ig + 3] + bb.w);
        }
      store_plain(acc, hid + (size_t)m * 256 + nt * 128, h);
    };
    gemm_block<false>(raw, rowp, 256, wt, 4096, mt * 256, nt * 128, smem, epi);
  }
}
DI void phase_mlp2(const Params& p, int layer, char* smem) {
  const int G = gridDim.x, bid = blockIdx.x;
  const int e = layer >> 1;
  char* ws = ows(p.ws);
  const float* c64 = (const float*)(ws + OFF_COS64);
  const float* s64 = (const float*)(ws + OFF_SIN64);
  for (int it = bid; it < 16; it += G) {
    const int kv = it >> 3, mt = it & 7;
    const u16* hid = (const u16*)(ws + E_HID) + (size_t)kv * 2048 * 256;
    const u16* wt = (const u16*)(ws + OFF_W2T) + (size_t)kv * 128 * 256;
    auto rowp = [&](int m) __attribute__((always_inline)) { return (u32)m * 256u; };
    auto epi = [&](f32x16(&acc)[4], int m, int h, int tok0) __attribute__((always_inline)) {
      int b, c, g;
      cmp_rowdec(m, b, c, g);
      if (m < 2044) {
        if (kv == 0) {
          norm_rope128<false>(acc, (const float*)(smem + GAIN_OFF), c64, s64, 16 * c + 31, h);
          store_plain(acc, (u16*)(ws + E_KC) + ((size_t)(b * 512 + c)) * 256 + g * 128, h);
        } else {
          store_vt(acc, (u16*)(ws + E_VCT) + (size_t)((b * 2 + g) * 128) * 512 + c, 512, h);
        }
      }
    };
    gemm_block<true>(hid, rowp, 128, wt, 256, mt * 256, 0, smem, epi, kv == 0 ? p.nsa_qk_gain + (e * 4 + 1) * 128 : nullptr);
  }
}

struct FS {
  f32x16 O[4];
  float m, l;
};
constexpr int KS_LD = 136, VS_LD = 68;
constexpr int KS_BYTES = 64 * KS_LD * 2, VS_BYTES = 128 * VS_LD * 2;

struct TileRegs {
  u32x4 k[4], v[4];
};
DI void tile_gload_k(TileRegs& tr, const u16* __restrict__ kb, int ldk) {
  const int tid = otid();
#pragma unroll
  for (int i = 0; i < 4; ++i) {
    const int c = tid + 256 * i;
    tr.k[i] = *(const u32x4*)(kb + (size_t)(c >> 4) * ldk + (c & 15) * 8);
  }
}
DI void tile_gload_v(TileRegs& tr, const u16* __restrict__ vb, int ldv) {
  const int tid = otid();
#pragma unroll
  for (int i = 0; i < 4; ++i) {
    const int c = tid + 256 * i;
    tr.v[i] = *(const u32x4*)(vb + (size_t)(c >> 3) * ldv + (c & 7) * 8);
  }
}
DI void tile_sstore_k(const TileRegs& tr, u16* Ks) {
  const int tid = otid();
#pragma unroll
  for (int i = 0; i < 4; ++i) {
    const int c = tid + 256 * i;
    *(u32x4*)(Ks + (c >> 4) * KS_LD + (c & 15) * 8) = tr.k[i];
  }
}
DI void tile_sstore_v(const TileRegs& tr, u16* Vs) {
  const int tid = otid();
#pragma unroll
  for (int i = 0; i < 4; ++i) {
    const int c = tid + 256 * i;
    u32x2* d = (u32x2*)(Vs + (c >> 3) * VS_LD + (c & 7) * 8);
    d[0] = mku2(tr.v[i].x, tr.v[i].y);
    d[1] = mku2(tr.v[i].z, tr.v[i].w);
  }
}

template <int NS>
DI void qk_tile(const u16* Ks, int kcol0, const bf16x8 (&qf)[NS], f32x16 (&S)[2], int r, int h) {
#pragma unroll
  for (int kt = 0; kt < 2; ++kt) {
    zero16(S[kt]);
#pragma unroll
    for (int s = 0; s < NS; ++s) {
      const bf16x8 a = *(const bf16x8*)(Ks + (32 * kt + r) * KS_LD + kcol0 + 16 * s + 8 * h);
      S[kt] = MFMA32(a, qf[s], S[kt]);
    }
  }
}
DI void pv_tile(const u16* Vs, const f32x16 (&P)[2], f32x16 (&O)[4], int r, int h) {
#pragma unroll
  for (int kt = 0; kt < 2; ++kt)
#pragma unroll
    for (int s = 0; s < 2; ++s) {
      u32x4 pu;
      pu.x = pk2(P[kt][8 * s + 0], P[kt][8 * s + 1]);
      pu.y = pk2(P[kt][8 * s + 2], P[kt][8 * s + 3]);
      pu.z = pk2(P[kt][8 * s + 4], P[kt][8 * s + 5]);
      pu.w = pk2(P[kt][8 * s + 6], P[kt][8 * s + 7]);
      const bf16x8 pf = __builtin_bit_cast(bf16x8, pu);
#pragma unroll
      for (int dt = 0; dt < 4; ++dt) {
        const u16* vp = Vs + (32 * dt + r) * VS_LD + 32 * kt + 16 * s + 4 * h;
        const u32x2 lo = *(const u32x2*)(vp);
        const u32x2 hi = *(const u32x2*)(vp + 8);
        const u32x4 vu = mku4(lo.x, lo.y, hi.x, hi.y);
        O[dt] = MFMA32(__builtin_bit_cast(bf16x8, vu), pf, O[dt]);
      }
    }
}

DI bool tile_on(u32 e0, u32 e1, u32 e2, u32 e3, int j) {
  const u32 wsel = j < 32 ? e0 : (j < 64 ? e1 : (j < 96 ? e2 : e3));
  return (wsel >> (j & 31)) & 1u;
}
DI int tile_next(u32 e0, u32 e1, u32 e2, u32 e3, int j, int j_hi) {
  while (j <= j_hi && !tile_on(e0, e1, e2, e3, j)) ++j;
  return j;
}

constexpr int TILE_BYTES = KS_BYTES + VS_BYTES;
constexpr int SELM_OFF = 2 * TILE_BYTES + 64;

template <class Mask>
DI float softmax_tile(f32x16 (&S)[2], FS& st, float scale2, Mask& mk, int j, int h) {
  mk.begin(j);
  const bool need = Mask::ALWAYS ? true : (__ballot(mk.needs(j)) != 0ull);
  if (need) {
#pragma unroll
    for (int kt = 0; kt < 2; ++kt)
#pragma unroll
      for (int i = 0; i < 16; ++i) {
        const bool ok = mk.ok(kt, i, j * 64 + 32 * kt + crow(i, h));
        S[kt][i] = ok ? S[kt][i] : -INFINITY;
      }
  }
  float mraw = -INFINITY;
#pragma unroll
  for (int kt = 0; kt < 2; ++kt)
#pragma unroll
    for (int i = 0; i < 16; ++i) mraw = fmaxf(mraw, S[kt][i]);
  mraw = fmaxf(mraw, __shfl_xor(mraw, 32));
  const float mold = st.m;
  const float mnew = mraw * scale2;
  float mx = mold;
  if (__ballot(mnew > mold + 8.f) != 0ull) mx = fmaxf(mold, mnew);
  const float alpha = __builtin_amdgcn_exp2f(mold - mx);
  float rs = 0.f;
#pragma unroll
  for (int kt = 0; kt < 2; ++kt)
#pragma unroll
    for (int i = 0; i < 16; ++i) {
      const float pv = __builtin_amdgcn_exp2f(__builtin_fmaf(S[kt][i], scale2, -mx));
      S[kt][i] = pv;
      rs += pv;
    }
  st.l = st.l * alpha + rs;
  st.m = mx;
  return alpha;
}

template <int NS, class Mask>
DI void flash_tiles(FS& st, const bf16x8 (&qf)[NS], const u16* __restrict__ kbase, int ldk, int kcol0,
                    const u16* __restrict__ vtbase, int ldv, int j_lo, int j_hi, u32 e0, u32 e1, u32 e2, u32 e3,
                    float scale2, Mask& mk, char* smem) {
  const int lane = otid() & 63, r = lane & 31, h = lane >> 5;
  int j = tile_next(e0, e1, e2, e3, j_lo, j_hi);
  if (j > j_hi) return;
  TileRegs tr;
  tile_gload_k(tr, kbase + (size_t)j * 64 * ldk, ldk);
  tile_gload_v(tr, vtbase + j * 64, ldv);
  __syncthreads();
  tile_sstore_k(tr, (u16*)smem);
  tile_sstore_v(tr, (u16*)(smem + KS_BYTES));
  int jn = tile_next(e0, e1, e2, e3, j + 1, j_hi);
  if (jn <= j_hi) {
    tile_gload_k(tr, kbase + (size_t)jn * 64 * ldk, ldk);
    tile_gload_v(tr, vtbase + jn * 64, ldv);
  }
  int cur = 0;
  while (true) {
    __syncthreads();
    int jnn = j_hi + 1;
    if (jn <= j_hi) {
      char* nb = smem + (cur ^ 1) * TILE_BYTES;
      tile_sstore_k(tr, (u16*)nb);
      tile_sstore_v(tr, (u16*)(nb + KS_BYTES));
      jnn = tile_next(e0, e1, e2, e3, jn + 1, j_hi);
      if (jnn <= j_hi) {
        tile_gload_k(tr, kbase + (size_t)jnn * 64 * ldk, ldk);
        tile_gload_v(tr, vtbase + jnn * 64, ldv);
      }
    }
    const u16* Ks = (const u16*)(smem + cur * TILE_BYTES);
    const u16* Vs = (const u16*)(smem + cur * TILE_BYTES + KS_BYTES);
    f32x16 S[2];
    __builtin_amdgcn_s_setprio(1);
    qk_tile<NS>(Ks, kcol0, qf, S, r, h);
    __builtin_amdgcn_s_setprio(0);
    const float alpha = softmax_tile(S, st, scale2, mk, j, h);
    if (__ballot(alpha != 1.f) != 0ull) {
#pragma unroll
      for (int dt = 0; dt < 4; ++dt)
#pragma unroll
        for (int i = 0; i < 16; ++i) st.O[dt][i] *= alpha;
    }
    __builtin_amdgcn_s_setprio(1);
    pv_tile(Vs, S, st.O, r, h);
    __builtin_amdgcn_s_setprio(0);
    if (jn > j_hi) break;
    j = jn;
    jn = jnn;
    cur ^= 1;
  }
}

struct MaskCausal {
  static constexpr bool ALWAYS = false;
  int t;
  DI void begin(int) {}
  DI bool needs(int j) const { return 64 * j + 63 > t; }
  DI bool ok(int, int, int key) const { return key <= t; }
};
struct MaskWin {
  static constexpr bool ALWAYS = false;
  int t;
  DI void begin(int) {}
  DI bool needs(int j) const { return 64 * j + 63 > t || 64 * j <= t - 512; }
  DI bool ok(int, int, int key) const { return key <= t && key > t - 512; }
};
struct MaskCmp {
  static constexpr bool ALWAYS = false;
  int cmax;
  DI void begin(int) {}
  DI bool needs(int j) const { return 64 * j + 63 > cmax; }
  DI bool ok(int, int, int key) const { return key <= cmax; }
};
struct MaskNone {
  static constexpr bool ALWAYS = false;
  DI void begin(int) {}
  DI bool needs(int) const { return false; }
  DI bool ok(int, int, int) const { return true; }
};
struct MaskSel {
  static constexpr bool ALWAYS = false;
  int t;
  u32 b0, b1, b2, b3;
  bool on;
  DI void begin(int j) { on = tile_on(b0, b1, b2, b3, j); }
  DI bool needs(int j) const { return !on || 64 * j + 63 > t; }
  DI bool ok(int, int, int key) const { return on && key <= t; }
};
struct MaskDsa {
  static constexpr bool ALWAYS = true;
  const u64* base;
  int sh;
  u32 lo, hi;
  DI void begin(int j) {
    const u64 w = base[(size_t)j * SEQ];
    lo = (u32)w >> sh;
    hi = (u32)(w >> 32) >> sh;
  }
  DI bool needs(int) const { return true; }
  DI bool ok(int kt, int i, int) const { return (((kt ? hi : lo) >> ((i & 3) + 8 * (i >> 2))) & 1u) != 0u; }
};

template <int NS>
DI void load_q(bf16x8 (&qf)[NS], const u16* __restrict__ qrow, int h) {
#pragma unroll
  for (int s = 0; s < NS; ++s) qf[s] = *(const bf16x8*)(qrow + 16 * s + 8 * h);
}
DI void fs_init(FS& st) {
#pragma unroll
  for (int i = 0; i < 4; ++i) zero16(st.O[i]);
  st.m = -3.0e38f;
  st.l = 0.f;
}
DI float fs_invl(const FS& st) {
  const float lt = st.l + __shfl_xor(st.l, 32);
  return lt > 0.f ? 1.f / lt : 0.f;
}

template <bool ACCUM>
DI void store_gated(const f32x16 (&O)[4], float coef, const u16* __restrict__ zrow, u16* __restrict__ yrow, int h) {
#pragma unroll
  for (int hb = 0; hb < 2; ++hb) {
    u32x2 zz[8], yy[8];
#pragma unroll
    for (int k = 0; k < 8; ++k) {
      const int dt = 2 * hb + (k >> 2), ig = k & 3;
      const int d = 32 * dt + 8 * ig + 4 * h;
      zz[k] = *(const u32x2*)(zrow + d);
      if (ACCUM) yy[k] = *(const u32x2*)(yrow + d);
    }
#pragma unroll
    for (int k = 0; k < 8; ++k) {
      const int dt = 2 * hb + (k >> 2), ig = k & 3;
      const int d = 32 * dt + 8 * ig + 4 * h;
      const u32x2 z2 = zz[k];
      float v0 = coef * O[dt][4 * ig] * siluf(bflo(z2.x));
      float v1 = coef * O[dt][4 * ig + 1] * siluf(bfhi(z2.x));
      float v2 = coef * O[dt][4 * ig + 2] * siluf(bflo(z2.y));
      float v3 = coef * O[dt][4 * ig + 3] * siluf(bfhi(z2.y));
      if (ACCUM) {
        const u32x2 y2 = yy[k];
        v0 += bflo(y2.x);
        v1 += bfhi(y2.x);
        v2 += bflo(y2.y);
        v3 += bfhi(y2.y);
      }
      u32x2 o;
      o.x = pk2(v0, v1);
      o.y = pk2(v2, v3);
      *(u32x2*)(yrow + d) = o;
    }
    __builtin_amdgcn_sched_barrier(0);
  }
}

constexpr u32 ALLON = 0xffffffffu;

DI void item_diff(const Params& p, int layer, int id, char* smem) {
  char* ws = ows(p.ws);
  const int e = layer >> 1;
  const int qt = 127 - (id >> 3), b = (id >> 2) & 1, hd = id & 3;
  const int tid = otid(), lane = tid & 63, w = tid >> 6, r = lane & 31, h = lane >> 5;
  const int c = w >> 1;
  const int t = qt * 64 + 32 * (w & 1) + r;
  const size_t tok = (size_t)b * SEQ + t;
  bf16x8 qf[4];
  load_q<4>(qf, (const u16*)(ws + E_BQ) + tok * 512 + hd * 128 + c * 64, h);
  FS st;
  fs_init(st);
  MaskCausal mk{t};
  flash_tiles<4>(st, qf, (const u16*)(ws + E_BK) + (size_t)b * SEQ * 512 + hd * 128, 512, 64 * c,
                       (const u16*)(ws + E_BVT) + (size_t)((b * 4 + hd) * 128) * SEQ, SEQ, 0, qt, ALLON, ALLON, ALLON,
                       ALLON, 0.125f * LOG2E, mk, smem);
  const float il = fs_invl(st);
  float* ex = (float*)smem;
  __syncthreads();
  if (c == 1) {
#pragma unroll
    for (int dt = 0; dt < 4; ++dt)
#pragma unroll
      for (int i = 0; i < 16; ++i) ex[((w & 1) * 64 + dt * 16 + i) * 64 + lane] = st.O[dt][i] * il;
  }
  __syncthreads();
  if (c == 0) {
    const float lambda_init = 0.8f - 0.6f * expf(-0.3f * (float)layer);
    const float lam = ((const float*)(ws + OFF_MISC))[e] + lambda_init;
    float ss = 0.f;
#pragma unroll
    for (int dt = 0; dt < 4; ++dt)
#pragma unroll
      for (int i = 0; i < 16; ++i) {
        const float a = st.O[dt][i] * il - lam * ex[((w & 1) * 64 + dt * 16 + i) * 64 + lane];
        st.O[dt][i] = a;
        ss += a * a;
      }
    ss += __shfl_xor(ss, 32);
    const float rinv = rsqrtf(ss * (1.f / 128.f) + EPS) * (1.f - lambda_init);
    const float* sg = p.diff_subln_gain + e * 128;
#pragma unroll
    for (int dt = 0; dt < 4; ++dt)
#pragma unroll
      for (int ig = 0; ig < 4; ++ig) {
        const f32x4 g = *(const f32x4*)(sg + 32 * dt + 8 * ig + 4 * h);
        st.O[dt][4 * ig] *= g.x;
        st.O[dt][4 * ig + 1] *= g.y;
        st.O[dt][4 * ig + 2] *= g.z;
        st.O[dt][4 * ig + 3] *= g.w;
      }
    store_gated<false>(st.O, rinv, (const u16*)(ws + OFF_Z) + tok * DM + 1024 + hd * 128,
                       (u16*)(ws + OFF_HY) + tok * DM + 1024 + hd * 128, h);
  }
}

DI void item_win(const Params& p, int id, char* smem) {
  char* ws = ows(p.ws);
  const int qt = id >> 2, b = (id >> 1) & 1, g = id & 1;
  const int tid = otid(), lane = tid & 63, w = tid >> 6, r = lane & 31, h = lane >> 5;
  const int t = qt * 32 + 8 * w + (r & 7), hq = 4 * g + (r >> 3);
  const size_t tok = (size_t)b * SEQ + t;
  bf16x8 qf[8];
  load_q<8>(qf, (const u16*)(ws + E_QA) + tok * 1024 + hq * 128, h);
  FS st;
  fs_init(st);
  MaskWin mk{t};
  int lo = qt * 32 - 511;
  lo = lo < 0 ? 0 : lo >> 6;
  flash_tiles<8>(st, qf, (const u16*)(ws + E_KW) + (size_t)b * SEQ * 256 + g * 128, 256, 0,
                       (const u16*)(ws + E_VWT) + (size_t)((b * 2 + g) * 128) * SEQ, SEQ, lo, (qt * 32 + 31) >> 6, ALLON,
                       ALLON, ALLON, ALLON, 0.08838834764831845f * LOG2E, mk, smem);
  const float il = fs_invl(st);
  const float gate = sigmf(((const float*)(ws + E_AG))[tok * 32 + hq * 3 + 2]);
  store_gated<false>(st.O, il * gate, (const u16*)(ws + OFF_Z) + tok * DM + hq * 128, (u16*)(ws + OFF_HY) + tok * DM + hq * 128,
                     h);
}

DI void item_sel(const Params& p, int id, char* smem) {
  char* ws = ows(p.ws);
  const int qt = 255 - (id >> 2), b = (id >> 1) & 1, g = id & 1;
  const int tid = otid(), lane = tid & 63, w = tid >> 6, r = lane & 31, h = lane >> 5;
  const int t = qt * 32 + 8 * w + (r & 7), hq = 4 * g + (r >> 3);
  const size_t tok = (size_t)b * SEQ + t;
  __syncthreads();
  const u32x4 sm4 = *(const u32x4*)((const u32*)(smem + SELM_OFF) + (8 * w + (r & 7)) * 4);
  u32 u0 = sm4.x, u1 = sm4.y, u2 = sm4.z, u3 = sm4.w;
#pragma unroll
  for (int o = 1; o <= 4; o <<= 1) {
    u0 |= __shfl_xor(u0, o);
    u1 |= __shfl_xor(u1, o);
    u2 |= __shfl_xor(u2, o);
    u3 |= __shfl_xor(u3, o);
  }
  u32* us = (u32*)(smem + 2 * TILE_BYTES);
  __syncthreads();
  if (lane == 0) {
    us[w * 4 + 0] = u0;
    us[w * 4 + 1] = u1;
    us[w * 4 + 2] = u2;
    us[w * 4 + 3] = u3;
  }
  __syncthreads();
  u0 = us[0] | us[4] | us[8] | us[12];
  u1 = us[1] | us[5] | us[9] | us[13];
  u2 = us[2] | us[6] | us[10] | us[14];
  u3 = us[3] | us[7] | us[11] | us[15];
  bf16x8 qf[8];
  load_q<8>(qf, (const u16*)(ws + E_QA) + tok * 1024 + hq * 128, h);
  FS st;
  fs_init(st);
  MaskSel mk{t, sm4.x, sm4.y, sm4.z, sm4.w, false};
  flash_tiles<8>(st, qf, (const u16*)(ws + E_KS) + (size_t)b * SEQ * 256 + g * 128, 256, 0,
                       (const u16*)(ws + E_VST) + (size_t)((b * 2 + g) * 128) * SEQ, SEQ, 0, (qt * 32 + 31) >> 6, u0, u1, u2,
                       u3, 0.08838834764831845f * LOG2E, mk, smem);
  const float il = fs_invl(st);
  const float gate = sigmf(((const float*)(ws + E_AG))[tok * 32 + hq * 3 + 1]);
  store_gated<true>(st.O, il * gate, (const u16*)(ws + OFF_Z) + tok * DM + hq * 128, (u16*)(ws + OFF_HY) + tok * DM + hq * 128,
                    h);
}

DI void item_cmp(const Params& p, int id, char* smem) {
  char* ws = ows(p.ws);
  const int qt = 255 - (id >> 2), b = (id >> 1) & 1, g = id & 1;
  const int tid = otid(), lane = tid & 63, w = tid >> 6, r = lane & 31, h = lane >> 5;
  const int tl = 8 * w + (r & 7);
  const int t = qt * 32 + tl, hq = 4 * g + (r >> 3);
  const size_t tok = (size_t)b * SEQ + t;
  const float scale2 = 0.08838834764831845f * LOG2E;
  u16* Ks = (u16*)smem;
  u16* Vs = (u16*)(smem + KS_BYTES);
  float* imp = (float*)(smem + KS_BYTES + VS_BYTES);
  __syncthreads();
  for (int i = tid; i < 32 * 132; i += NTHREADS) imp[i] = 0.f;
  bf16x8 qf[8];
  load_q<8>(qf, (const u16*)(ws + E_QA) + tok * 1024 + hq * 128, h);
  FS st;
  fs_init(st);
  MaskCmp mk{t >= 31 ? ((t - 31) >> 4) : -1};
  const int j_hi = qt >> 5;
  const u16* kbase = (const u16*)(ws + E_KC) + (size_t)b * 512 * 256 + g * 128;
  const u16* vtbase = (const u16*)(ws + E_VCT) + (size_t)((b * 2 + g) * 128) * 512;
  for (int j = 0; j <= j_hi; ++j) {
    TileRegs tr;
    tile_gload_k(tr, kbase + (size_t)j * 64 * 256, 256);
    __syncthreads();
    tile_sstore_k(tr, Ks);
    __syncthreads();
    f32x16 S[2];
    qk_tile<8>(Ks, 0, qf, S, r, h);
    softmax_tile(S, st, scale2, mk, j, h);
  }
  const float il = fs_invl(st);
  const float mfin = st.m;
  for (int j = 0; j <= j_hi; ++j) {
    TileRegs tr;
    tile_gload_k(tr, kbase + (size_t)j * 64 * 256, 256);
    tile_gload_v(tr, vtbase + j * 64, 512);
    __syncthreads();
    tile_sstore_k(tr, Ks);
    tile_sstore_v(tr, Vs);
    __syncthreads();
    f32x16 S[2];
    qk_tile<8>(Ks, 0, qf, S, r, h);
#pragma unroll
    for (int kt = 0; kt < 2; ++kt) {
#pragma unroll
      for (int i = 0; i < 16; ++i) {
        const int key = j * 64 + 32 * kt + crow(i, h);
        S[kt][i] = key <= mk.cmax ? __builtin_amdgcn_exp2f(S[kt][i] * scale2 - mfin) * il : 0.f;
      }
#pragma unroll
      for (int ig = 0; ig < 4; ++ig) {
        float vm = S[kt][4 * ig] + S[kt][4 * ig + 1] + S[kt][4 * ig + 2] + 0.5f * S[kt][4 * ig + 3];
        float vn = 0.5f * S[kt][4 * ig + 3];
        vm += __shfl_xor(vm, 8);
        vn += __shfl_xor(vn, 8);
        vm += __shfl_xor(vm, 16);
        vn += __shfl_xor(vn, 16);
        if ((r >> 3) == 0) {
          const int jj = 16 * j + 8 * kt + 2 * ig + h;
          atomicAdd(&imp[tl * 132 + jj], vm);
          atomicAdd(&imp[tl * 132 + jj + 1], vn);
        }
      }
    }
    pv_tile(Vs, S, st.O, r, h);
  }
  const float gate = sigmf(((const float*)(ws + E_AG))[tok * 32 + hq * 3 + 0]);
  store_gated<true>(st.O, gate, (const u16*)(ws + OFF_Z) + tok * DM + hq * 128, (u16*)(ws + OFF_HY) + tok * DM + hq * 128, h);
  __syncthreads();
  for (int q = 0; q < 8; ++q) {
    const int tl2 = 8 * w + q;
    const int t2 = qt * 32 + tl2;
    const int cur = t2 >> 6;
    const int j0 = lane, j1 = lane + 64;
    float v0 = j0 > cur ? -1e30f : ((j0 == 0 || j0 >= cur - 1) ? 1e9f : imp[tl2 * 132 + j0]);
    float v1 = j1 > cur ? -1e30f : ((j1 >= cur - 1) ? 1e9f : imp[tl2 * 132 + j1]);
    u32 m0 = 0, m1 = 0, m2 = 0, m3 = 0;
    for (int rd = 0; rd < 16; ++rd) {
      float bv = v0;
      int bj = j0;
      if (v1 > v0) {
        bv = v1;
        bj = j1;
      }
#pragma unroll
      for (int o = 32; o >= 1; o >>= 1) {
        const float ov = __shfl_xor(bv, o);
        const int oj = __shfl_xor(bj, o);
        if (ov > bv || (ov == bv && oj < bj)) {
          bv = ov;
          bj = oj;
        }
      }
      const u32 bit = 1u << (bj & 31);
      if (bj < 32) m0 |= bit;
      else if (bj < 64) m1 |= bit;
      else if (bj < 96) m2 |= bit;
      else m3 |= bit;
      if (bj == j0) v0 = -3e38f;
      if (bj == j1) v1 = -3e38f;
    }
    const int nb = cur + 1;
    const u32 k0 = nb >= 32 ? ALLON : ((1u << nb) - 1u);
    const u32 k1 = nb >= 64 ? ALLON : (nb <= 32 ? 0u : ((1u << (nb - 32)) - 1u));
    const u32 k2 = nb >= 96 ? ALLON : (nb <= 64 ? 0u : ((1u << (nb - 64)) - 1u));
    const u32 k3 = nb >= 128 ? ALLON : (nb <= 96 ? 0u : ((1u << (nb - 96)) - 1u));
    if (lane == 0)
      *(u32x4*)((u32*)(smem + SELM_OFF) + tl2 * 4) = mku4(m0 & k0, m1 & k1, m2 & k2, m3 & k3);
  }
}

DI void item_mem(const Params& p, int layer, int id, char* smem) {
  char* ws = ows(p.ws);
  const int par = layer & 1;
  const int qt = id >> 3, b = (id >> 2) & 1, hm = id & 3;
  const int tid = otid(), lane = tid & 63, w = tid >> 6, r = lane & 31, h = lane >> 5;
  const int t = qt * 128 + 32 * w + r;
  const size_t tok = (size_t)b * SEQ + t;
  bf16x8 qf[8];
  load_q<8>(qf, (const u16*)(ws + (par ? O_MQ : E_MQ)) + tok * 512 + hm * 128, h);
  FS st;
  fs_init(st);
  MaskNone mk;
  flash_tiles<8>(st, qf, (const u16*)(ws + OFF_MEMK) + ((size_t)layer * 512 + b * 256) * 512 + hm * 128, 512, 0,
                       (const u16*)(ws + OFF_MEMVT) + (size_t)(((layer * 2 + b) * 4 + hm) * 128) * 256, 256, 0, 3, ALLON,
                       ALLON, ALLON, ALLON, 0.08838834764831845f * LOG2E, mk, smem);
  const float il = fs_invl(st);
  store_gated<false>(st.O, il, (const u16*)(ws + OFF_Z) + tok * DM + 1536 + hm * 128,
                     (u16*)(ws + OFF_HY) + tok * DM + 1536 + hm * 128, h);
}

DI void item_dsa(const Params& p, int id, char* smem) {
  char* ws = ows(p.ws);
  const int qt = 63 - id / 24, rem = id % 24, b = rem / 12, hd = rem % 12, g = hd / 3;
  const int tid = otid(), lane = tid & 63, w = tid >> 6, r = lane & 31, h = lane >> 5;
  const int t = qt * 128 + 32 * w + r;
  const size_t tok = (size_t)b * SEQ + t;
  bf16x8 qf[8];
  load_q<8>(qf, (const u16*)(ws + O_CQ) + tok * 1536 + hd * 128, h);
  FS st;
  fs_init(st);
  MaskDsa mk{(const u64*)(ws + O_DMASK) + (size_t)b * 128 * SEQ + t, 4 * h, 0u, 0u};
  flash_tiles<8>(st, qf, (const u16*)(ws + O_CK) + (size_t)b * SEQ * 512 + g * 128, 512, 0,
                       (const u16*)(ws + O_CVT) + (size_t)((b * 4 + g) * 128) * SEQ, SEQ, 0, 2 * qt + 1, ALLON, ALLON, ALLON,
                       ALLON, 0.08838834764831845f * LOG2E, mk, smem);
  const float il = fs_invl(st);
  store_gated<false>(st.O, il, (const u16*)(ws + OFF_Z) + tok * DM + hd * 128, (u16*)(ws + OFF_HY) + tok * DM + hd * 128, h);
}

DI size_t sc_row(int b, int t) {
  const int q = t >> 7;
  return (size_t)b * SC_PER_B + (size_t)16384 * (q * (q + 1) / 2) + (size_t)(t & 127) * (128 * (q + 1));
}
constexpr int QS_LD = 1032;
DI void item_idx(const Params& p, int b, int qt32, int ch, char* smem) {
  char* ws = ows(p.ws);
  u16* Qs = (u16*)smem;
  float* wsm = (float*)(smem + 32 * QS_LD * 2);
  const int tid = otid(), lane = tid & 63, w = tid >> 6, r = lane & 31, h = lane >> 5;
  const int q0 = qt32 * 32;
  const int Lq = 128 * ((q0 >> 7) + 1);
  __syncthreads();
  {
    const u16* iq = (const u16*)(ws + O_IQ) + ((size_t)b * SEQ + q0) * 1024;
#pragma unroll
    for (int i = 0; i < 16; ++i) {
      const int c = tid + 256 * i;
      *(u32x4*)(Qs + (c >> 7) * QS_LD + (c & 127) * 8) = *(const u32x4*)(iq + (size_t)(c >> 7) * 1024 + (c & 127) * 8);
    }
    const float* iw = (const float*)(ws + O_IW) + ((size_t)b * SEQ + q0) * 16;
    for (int i = tid; i < 512; i += NTHREADS) wsm[i] = iw[i];
  }
  __syncthreads();
  const int key0 = ch * 512 + 128 * w;
  if (key0 >= Lq) return;
  const u16* ik = (const u16*)(ws + O_IK) + ((size_t)b * SEQ + key0) * 64;
  bf16x8 kf[4][4];
#pragma unroll
  for (int sub = 0; sub < 4; ++sub)
#pragma unroll
    for (int s = 0; s < 4; ++s) kf[sub][s] = *(const bf16x8*)(ik + (size_t)(32 * sub + r) * 64 + 16 * s + 8 * h);
  f32x16 acc[4];
#pragma unroll
  for (int i = 0; i < 4; ++i) zero16(acc[i]);
#pragma unroll 1
  for (int hh = 0; hh < 16; ++hh) {
    const float wv = wsm[r * 16 + hh];
    bf16x8 qf[4];
#pragma unroll
    for (int s = 0; s < 4; ++s) qf[s] = *(const bf16x8*)(Qs + r * QS_LD + hh * 64 + 16 * s + 8 * h);
#pragma unroll
    for (int sub = 0; sub < 4; ++sub) {
      f32x16 sx;
      zero16(sx);
      __builtin_amdgcn_s_setprio(1);
#pragma unroll
      for (int s = 0; s < 4; ++s) sx = MFMA32(kf[sub][s], qf[s], sx);
      __builtin_amdgcn_s_setprio(0);
#pragma unroll
      for (int i = 0; i < 16; ++i) {
        const float xf = sx[i];
        const int xb = __float_as_int(xf);
        acc[sub][i] += wv * __int_as_float(xb > 0 ? xb : 0);
      }
    }
  }
  const int t = q0 + r;
  u16* srow = (u16*)(ws + O_SC) + sc_row(b, t) + key0;
#pragma unroll
  for (int sub = 0; sub < 4; ++sub)
#pragma unroll
    for (int ig = 0; ig < 4; ++ig) {
      u16 hv[4];
#pragma unroll
      for (int q = 0; q < 4; ++q) {
        const _Float16 f = (_Float16)acc[sub][4 * ig + q];
        hv[q] = __builtin_bit_cast(u16, f);
      }
      u32x2 o;
      o.x = (u32)hv[0] | ((u32)hv[1] << 16);
      o.y = (u32)hv[2] | ((u32)hv[3] << 16);
      *(u32x2*)(srow + 32 * sub + 8 * ig + 4 * h) = o;
    }
}
DI void phase_idx(const Params& p, char* smem) {
  const int G = gridDim.x;
  for (int it = blockIdx.x; it < 2 * 2176; it += G) {
    const int b = it & 1;
    const int idx = it >> 1;
    int q4 = 0;
    while (q4 < 15 && 8 * (q4 + 1) * (q4 + 2) <= idx) ++q4;
    const int rem = idx - 8 * q4 * (q4 + 1);
    const int ch = rem >> 4, qt32 = q4 * 16 + (rem & 15);
    item_idx(p, b, qt32, ch, smem);
  }
}

DI u32 okey(u32 hbits) { return (hbits & 0x8000u) ? (~hbits & 0xffffu) : (hbits | 0x8000u); }
DI void wave_lds_sync() {
  __builtin_amdgcn_fence(__ATOMIC_SEQ_CST, "workgroup");
  __builtin_amdgcn_wave_barrier();
}
DI int find_bin(const u32* hist, int lane, u32 target, u32& above) {
  const u32 c0 = hist[4 * lane], c1 = hist[4 * lane + 1], c2 = hist[4 * lane + 2], c3 = hist[4 * lane + 3];
  const u32 tot = c0 + c1 + c2 + c3;
  u32 suf = tot;
#pragma unroll
  for (int o = 1; o < 64; o <<= 1) {
    const u32 v = __shfl_down(suf, o);
    if (lane + o < 64) suf += v;
  }
  const u64 bal = __ballot(suf >= target);
  const int sl = 63 - __builtin_clzll(bal | 1ull);
  u32 a = suf - tot;
  int bin;
  if (a + c3 >= target) bin = 3;
  else {
    a += c3;
    if (a + c2 >= target) bin = 2;
    else {
      a += c2;
      if (a + c1 >= target) bin = 1;
      else {
        a += c1;
        bin = 0;
      }
    }
  }
  const int resb = __shfl(4 * lane + bin, sl);
  above = __shfl(a, sl);
  return resb;
}
DI void phase_select(const Params& p, char* smem) {
  char* ws = ows(p.ws);
  const int tid = otid(), lane = tid & 63, w = tid >> 6;
  u32* hist = (u32*)smem + w * 256;
  const int gw = blockIdx.x * 4 + w, nw = gridDim.x * 4;
  u64* dmask = (u64*)(ws + O_DMASK);
  for (int row = gw; row < NTOK; row += nw) {
    const int b = row & 1, t = SEQ - 1 - (row >> 1);
    const int L = t + 1;
    const u16* srow = (const u16*)(ws + O_SC) + sc_row(b, t);
    u32 T = 0, need = 0x7fffffffu;
    const bool all = L <= 256;
    if (!all) {
      const int nit = (L + 511) >> 9;
      wave_lds_sync();
#pragma unroll
      for (int i = 0; i < 4; ++i) hist[lane + 64 * i] = 0;
      wave_lds_sync();
      for (int it = 0; it < nit; ++it) {
        const int i0 = it * 512 + lane * 8;
        const u32x4 v = *(const u32x4*)(srow + i0);
        const u32 vv[4] = {v.x, v.y, v.z, v.w};
#pragma unroll
        for (int q = 0; q < 8; ++q) {
          const u32 k = okey((vv[q >> 1] >> (16 * (q & 1))) & 0xffffu);
          if (i0 + q <= t) atomicAdd(&hist[k >> 8], 1u);
        }
      }
      wave_lds_sync();
      u32 above1;
      const int b1 = find_bin(hist, lane, 256u, above1);
      wave_lds_sync();
#pragma unroll
      for (int i = 0; i < 4; ++i) hist[lane + 64 * i] = 0;
      wave_lds_sync();
      for (int it = 0; it < nit; ++it) {
        const int i0 = it * 512 + lane * 8;
        const u32x4 v = *(const u32x4*)(srow + i0);
        const u32 vv[4] = {v.x, v.y, v.z, v.w};
#pragma unroll
        for (int q = 0; q < 8; ++q) {
          const u32 k = okey((vv[q >> 1] >> (16 * (q & 1))) & 0xffffu);
          if (i0 + q <= t && (int)(k >> 8) == b1) atomicAdd(&hist[k & 255u], 1u);
        }
      }
      wave_lds_sync();
      u32 above2;
      const int b2 = find_bin(hist, lane, 256u - above1, above2);
      T = ((u32)b1 << 8) | (u32)b2;
      need = 256u - above1 - above2;
    }
    const int ktmax = 2 * (t >> 7) + 1;
    const int nit3 = (ktmax + 1 + 7) >> 3;
    u32 tie_base = 0;
    for (int it = 0; it < nit3; ++it) {
      const int i0 = it * 512 + lane * 8;
      const u32x4 v = *(const u32x4*)(srow + i0);
      const u32 vv[4] = {v.x, v.y, v.z, v.w};
      u32 kk[8];
      u32 tc = 0;
#pragma unroll
      for (int q = 0; q < 8; ++q) {
        kk[q] = okey((vv[q >> 1] >> (16 * (q & 1))) & 0xffffu);
        if (i0 + q <= t && kk[q] == T) ++tc;
      }
      u32 inc = tc;
#pragma unroll
      for (int o = 1; o < 64; o <<= 1) {
        const u32 x = __shfl_up(inc, o);
        if (lane >= o) inc += x;
      }
      u32 rank = tie_base + inc - tc;
      tie_base += __shfl(inc, 63);
      u32 byte = 0;
#pragma unroll
      for (int q = 0; q < 8; ++q) {
        const bool valid = i0 + q <= t;
        bool s = false;
        if (valid) {
          if (all || kk[q] > T) s = true;
          else if (kk[q] == T) {
            s = rank < need;
            ++rank;
          }
        }
        byte |= (s ? 1u : 0u) << q;
      }
      const int sh = 8 * (lane & 7);
      u32 wlo = sh < 32 ? (byte << sh) : 0u;
      u32 whi = sh >= 32 ? (byte << (sh - 32)) : 0u;
#pragma unroll
      for (int o = 1; o <= 4; o <<= 1) {
        wlo |= __shfl_xor(wlo, o);
        whi |= __shfl_xor(whi, o);
      }
      const int kt = it * 8 + (lane >> 3);
      if ((lane & 7) == 0 && kt <= ktmax) dmask[((size_t)b * 128 + kt) * SEQ + t] = ((u64)whi << 32) | (u64)wlo;
    }
  }
}


#define XB_TMO      128
#define XB_XCNT(j)  (256  + 64 * (j))
#define XB_XSUB(j)  (1280 + 64 * (j))
#define XB_XGEN(j)  (2304 + 64 * (j))
#define XB_TOP      3328
#define XB_TOPGEN   3392
#define XCD_BAR_WORDS 3456
#define XB_SPIN_CAP (1u << 22)
#define LAS __attribute__((address_space(3)))
DI unsigned xb_ld(unsigned* p) { return __hip_atomic_load(p, __ATOMIC_RELAXED, __HIP_MEMORY_SCOPE_AGENT); }
DI unsigned xb_add(unsigned* p, unsigned v) { return __hip_atomic_fetch_add(p, v, __ATOMIC_RELAXED, __HIP_MEMORY_SCOPE_AGENT); }
DI unsigned xb_xcc_id() { return (unsigned)__builtin_amdgcn_s_getreg((3 << 11) | 20) & 0xFu; }
#define XB_SPIN(cond, bar) do { unsigned _sp = 0; while (cond) { __builtin_amdgcn_s_sleep(1); \
    if ((++_sp & 255u) == 0u) { if (xb_ld(&(bar)[XB_TMO])) break; if (_sp > XB_SPIN_CAP) { atomicAdd(&(bar)[XB_TMO], 1u); break; } } } } while (0)
struct XcdBarrier {
  unsigned* bar;
  unsigned x;
  volatile LAS unsigned* st;
};
DI void xcd_barrier_complete(unsigned* bar, unsigned x, unsigned& nloc, unsigned& nx) {
  const unsigned G = gridDim.x * gridDim.y * gridDim.z;
  unsigned sum, cnt, mine, sp = 0u;
  for (;;) {
    sum = 0u; cnt = 0u; mine = 0u;
#pragma unroll 1
    for (unsigned j = 0; j < 16; ++j) { const unsigned c = xb_ld(&bar[XB_XCNT(j)]); sum += c; cnt += (c > 0u) ? 1u : 0u; mine = (j == x) ? c : mine; }
    if (sum == G) break;
    __builtin_amdgcn_s_sleep(1);
    if ((++sp & 255u) == 0u) { if (xb_ld(&bar[XB_TMO])) break; if (sp > XB_SPIN_CAP) { atomicAdd(&bar[XB_TMO], 1u); break; } }
  }
  nloc = mine > 0u ? mine : 1u; nx = cnt > 0u ? cnt : 1u;
}
DI void xcd_barrier(const XcdBarrier& b) {
  asm volatile("s_waitcnt vmcnt(0)" ::: "memory");
  __syncthreads();
  if (__builtin_amdgcn_workitem_id_x() == 0) {
    unsigned* bar = (unsigned*)ows((char*)b.bar);
    __builtin_amdgcn_s_waitcnt(0);
    unsigned nloc = b.st[0], nx = b.st[1];
    if (nloc == 0u) { xcd_barrier_complete(bar, b.x, nloc, nx); b.st[0] = nloc; b.st[1] = nx; }
    const unsigned old = xb_add(&bar[XB_XSUB(b.x)], 1u);
    const unsigned gen = old / nloc;
    if (old + 1u == (gen + 1u) * nloc) {
      __builtin_amdgcn_fence(__ATOMIC_RELEASE, "agent");
      asm volatile("s_waitcnt vmcnt(0)" ::: "memory");
      const unsigned og = xb_add(&bar[XB_TOP], 1u);
      const unsigned tg = og / nx;
      if (og + 1u == (tg + 1u) * nx) xb_add(&bar[XB_TOPGEN], 1u);
      else XB_SPIN(xb_ld(&bar[XB_TOPGEN]) == tg, bar);
      __builtin_amdgcn_fence(__ATOMIC_ACQUIRE, "agent");
      xb_add(&bar[XB_XGEN(b.x)], 1u);
      asm volatile("s_waitcnt vmcnt(0)" ::: "memory");
    } else {
      XB_SPIN(xb_ld(&bar[XB_XGEN(b.x)]) == gen, bar);
      __builtin_amdgcn_fence(__ATOMIC_ACQUIRE, "agent");
      asm volatile("s_waitcnt vmcnt(0)" ::: "memory");
    }
  }
  __syncthreads();
}

DI XcdInfo xcd_info(const XcdBarrier& b, int* s_tmp) {
  __syncthreads();
  if (__builtin_amdgcn_workitem_id_x() == 0) {
    int xi = 0;
    unsigned* bar = (unsigned*)ows((char*)b.bar);
#pragma unroll 1
    for (unsigned j = 0; j < 16; ++j) {
      const unsigned c = xb_ld(&bar[XB_XCNT(j)]);
      if (j < b.x && c > 0u) ++xi;
    }
    s_tmp[0] = xi;
  }
  __syncthreads();
  XcdInfo r;
  r.xi = s_tmp[0];
  r.nloc = (int)b.st[0];
  r.nx = (int)b.st[1];
  r.lrank = (int)b.st[2];
  return r;
}

DI void run_phase(const Params& p, int ph, char* smem, int* s_item, const XcdBarrier& xb) {
  int layer, lp;
  if (ph < 6) { layer = 0; lp = ph; }
  else if (ph < 12) { layer = 1; lp = ph - 6; }
  else if (ph < 18) { layer = 2; lp = ph - 12; }
  else { layer = 3; lp = ph - 18; }
  int* ctr = (int*)(ows(p.ws) + OFF_CTR) + layer * 8;
  if (!(layer & 1)) {
    switch (lp) {
      case 0: phase_prep(p, layer, smem); break;
      case 1: phase_proj(p, layer, smem, xcd_info(xb, s_item)); break;
      case 2: {
        mlp1_tiles(p, smem);
        int it;
        while ((it = next_item(ctr + 0, s_item)) < 2560) {
          if (it < 1024) item_diff(p, layer, it, smem);
          else if (it < 2048) item_win(p, it - 1024, smem);
          else item_mem(p, layer, it - 2048, smem);
        }
      } break;
      case 3: phase_mlp2(p, layer, smem); break;
      case 4: {
        int it;
        while ((it = next_item(ctr + 1, s_item)) < 1024) {
          item_cmp(p, it, smem);
          item_sel(p, it, smem);
        }
      } break;
      default: phase_outproj(p, layer, smem, xcd_info(xb, s_item)); break;
    }
  } else {
    switch (lp) {
      case 0: phase_prep(p, layer, smem); break;
      case 1: phase_proj(p, layer, smem, xcd_info(xb, s_item)); break;
      case 2: {
        phase_idx(p, smem);
        int it;
        while ((it = next_item(ctr + 0, s_item)) < 512) item_mem(p, layer, it, smem);
      } break;
      case 3: phase_select(p, smem); break;
      case 4: {
        int it;
        while ((it = next_item(ctr + 1, s_item)) < 1536) item_dsa(p, it, smem);
      } break;
      default: phase_outproj(p, layer, smem, xcd_info(xb, s_item)); break;
    }
  }
}

constexpr int SMEM_BYTES = 2 * TILE_BYTES + 64 + 512;
constexpr int N_PHASES = 24;

__global__ void __launch_bounds__(NTHREADS, 2) trunk_megakernel(Params p) {
  __shared__ __attribute__((aligned(16))) char smem[SMEM_BYTES];
  __shared__ int s_item;
  __shared__ u32x4 xb_words;
  cg::grid_group grid = cg::this_grid();
  XcdBarrier xb;
  xb.bar = (unsigned*)(p.ws + OFF_BAR);
  xb.x = xb_xcc_id();
  xb.st = (volatile LAS unsigned*)&xb_words;
  if (__builtin_amdgcn_workitem_id_x() == 0) {
    xb.st[0] = 0u;
    xb.st[1] = 0u;
  }
  __syncthreads();
  if (__builtin_amdgcn_workitem_id_x() == 0) xb.st[2] = xb_add(&xb.bar[XB_XCNT(xb.x)], 1u);
  if (p.ph_end < 0) grid.sync();
  if (p.ph_begin == 0) phase_prep0_extra(p, smem);
  for (int ph = p.ph_begin; ph < p.ph_end; ++ph) {
    run_phase(p, ph, smem, &s_item, xb);
    if (ph + 1 < p.ph_end) xcd_barrier(xb);
  }
}

extern "C" void kernel_launch(void* const* d_in, const int* in_sizes, int n_in, void* d_out, int out_size, void* d_ws,
                              size_t ws_size, hipStream_t stream) {
  static int grid_blocks = 0;
  if (!grid_blocks) {
    int dev = 0, cus = 0, per_cu = 0;
    (void)hipGetDevice(&dev);
    (void)hipDeviceGetAttribute(&cus, hipDeviceAttributeMultiprocessorCount, dev);
    (void)hipOccupancyMaxActiveBlocksPerMultiprocessor(&per_cu, trunk_megakernel, NTHREADS, 0);
    if (per_cu > 2) per_cu = 2;
    if (per_cu < 1) per_cu = 1;
    grid_blocks = cus * per_cu;
  }
  Params p;
  memset(&p, 0, sizeof(p));
  p.x = (const float*)d_in[0];
  p.mem = (const float*)d_in[1];
  p.norm_gain = (const float*)d_in[2];
  p.mem_norm_gain = (const float*)d_in[3];
  p.mem_w_kv = (const float*)d_in[4];
  p.mem_qk_gain = (const float*)d_in[5];
  p.w_out = (const float*)d_in[6];
  p.even_w_in = (const float*)d_in[7];
  p.nsa_qk_gain = (const float*)d_in[8];
  p.nsa_cmp_pos = (const float*)d_in[9];
  p.nsa_cmp_w1 = (const float*)d_in[10];
  p.nsa_cmp_w2 = (const float*)d_in[11];
  p.diff_qk_gain = (const float*)d_in[12];
  p.diff_lambda = (const float*)d_in[13];
  p.diff_subln_gain = (const float*)d_in[14];
  p.odd_w_in = (const float*)d_in[15];
  p.dsa_qk_gain = (const float*)d_in[16];
  p.out = (float*)d_out;
  p.ws = (char*)d_ws;
  p.ph_begin = 0;
  p.ph_end = N_PHASES;
  (void)hipMemsetAsync(d_ws, 0, 4096, stream);
  (void)hipMemsetAsync((char*)d_ws + OFF_BAR, 0, 16384, stream);
  void* args[] = {&p};
  hipError_t err = hipLaunchCooperativeKernel((void*)trunk_megakernel, dim3(grid_blocks), dim3(NTHREADS), args, 0, stream);
  if (err != hipSuccess) fprintf(stderr, "cooperative launch failed: %s (grid %d)\n", hipGetErrorString(err), grid_blocks);
}
```

```cpp
#include <hip/hip_runtime.h>
#include <hip/hip_cooperative_groups.h>
#include <stdint.h>
#include <stdio.h>
#include <string.h>
namespace cg = cooperative_groups;

#define DI __device__ __forceinline__
typedef unsigned short u16;
typedef unsigned int u32;
typedef unsigned long long u64;
typedef __attribute__((ext_vector_type(8))) short bf16x8;
typedef __attribute__((ext_vector_type(16))) float f32x16;
typedef __attribute__((ext_vector_type(2))) float f32x2;
typedef __attribute__((ext_vector_type(4))) float f32x4;
typedef __attribute__((ext_vector_type(4))) unsigned int u32x4;
typedef __attribute__((ext_vector_type(2))) unsigned int u32x2;
typedef __attribute__((ext_vector_type(2))) __bf16 bf16x2;
#define MFMA32(a, b, c) __builtin_amdgcn_mfma_f32_32x32x16_bf16((a), (b), (c), 0, 0, 0)

constexpr int NB = 2, SEQ = 8192, DM = 2048, NTOK = NB * SEQ;
constexpr int EVEN_IN = 6680, ODD_IN = 6224, EVEN_NT = 53, ODD_NT = 49;
constexpr float EPS = 1e-6f;
constexpr float LOG2E = 1.4426950408889634f;
constexpr int NTHREADS = 256;

constexpr size_t MiB = 1ull << 20;
constexpr size_t OFF_CTR = 0;
constexpr size_t OFF_MISC = 4096;
constexpr size_t OFF_COS64 = 8192;
constexpr size_t OFF_SIN64 = OFF_COS64 + 2 * MiB;
constexpr size_t OFF_COS32 = OFF_SIN64 + 2 * MiB;
constexpr size_t OFF_SIN32 = OFF_COS32 + 1 * MiB;
constexpr size_t OFF_MEMN = OFF_SIN32 + 1 * MiB;
constexpr size_t OFF_MEMK = OFF_MEMN + 2 * MiB;
constexpr size_t OFF_MEMVT = OFF_MEMK + 2 * MiB;
constexpr size_t OFF_WKVT = OFF_MEMVT + 2 * MiB;
constexpr size_t OFF_WTIN = OFF_WKVT + 16 * MiB;
constexpr size_t OFF_WTOUT = OFF_WTIN + 27 * MiB;
constexpr size_t OFF_W1T = OFF_WTOUT + 8 * MiB;
constexpr size_t OFF_W2T = OFF_W1T + 4 * MiB;
constexpr size_t OFF_CBIAS = OFF_W2T + 128 * 1024;
constexpr size_t OFF_CBPART = OFF_CBIAS + 4096;
constexpr size_t OFF_BAR = OFF_CBPART + 131072;
constexpr size_t OFF_HY = OFF_CBIAS + 4096 + 8192 + (MiB - 128 * 1024 - 4096 - 8192 - 8192);
constexpr size_t OFF_Z = OFF_HY + 64 * MiB;
constexpr size_t OFF_L = OFF_Z + 64 * MiB;
constexpr size_t E_QA = OFF_L;
constexpr size_t E_KCRAW = E_QA + 32 * MiB;
constexpr size_t E_VCRAW = E_KCRAW + 8 * MiB;
constexpr size_t E_KS = E_VCRAW + 8 * MiB;
constexpr size_t E_VST = E_KS + 8 * MiB;
constexpr size_t E_KW = E_VST + 8 * MiB;
constexpr size_t E_VWT = E_KW + 8 * MiB;
constexpr size_t E_AG = E_VWT + 8 * MiB;
constexpr size_t E_BQ = E_AG + 2 * MiB;
constexpr size_t E_BK = E_BQ + 16 * MiB;
constexpr size_t E_BVT = E_BK + 16 * MiB;
constexpr size_t E_MQ = E_BVT + 16 * MiB;
constexpr size_t E_KC = E_MQ + 16 * MiB;
constexpr size_t E_VCT = E_KC + MiB / 2;
constexpr size_t E_HID = E_VCT + MiB / 2;
constexpr size_t E_SELM = E_HID + 2 * MiB;
constexpr size_t E_END = E_SELM + MiB / 2;
constexpr size_t O_CQ = OFF_L;
constexpr size_t O_CK = O_CQ + 48 * MiB;
constexpr size_t O_CVT = O_CK + 16 * MiB;
constexpr size_t O_IQ = O_CVT + 16 * MiB;
constexpr size_t O_IK = O_IQ + 32 * MiB;
constexpr size_t O_IW = O_IK + 2 * MiB;
constexpr size_t O_MQ = O_IW + 1 * MiB;
constexpr size_t O_DMASK = O_MQ + 16 * MiB;
constexpr size_t O_SC = O_DMASK + 16 * MiB;
constexpr size_t SC_PER_B = 16384ull * (64 * 65 / 2);
constexpr size_t O_END = O_SC + 2 * SC_PER_B * 2;

struct Params {
  const float *x, *mem, *norm_gain, *mem_norm_gain, *mem_w_kv, *mem_qk_gain, *w_out, *even_w_in, *nsa_qk_gain,
      *nsa_cmp_pos, *nsa_cmp_w1, *nsa_cmp_w2, *diff_qk_gain, *diff_lambda, *diff_subln_gain, *odd_w_in, *dsa_qk_gain;
  float* out;
  char* ws;
  int ph_begin, ph_end;
};

DI u16 f2bf(float x) {
  u32 u = __float_as_uint(x);
  u += 0x7fffu + ((u >> 16) & 1u);
  return (u16)(u >> 16);
}
DI u32x4 mku4(u32 a, u32 b, u32 c, u32 d) { u32x4 r = {a, b, c, d}; return r; }
DI u32x2 mku2(u32 a, u32 b) { u32x2 r = {a, b}; return r; }
DI f32x4 mkf4(float a, float b, float c, float d) { f32x4 r = {a, b, c, d}; return r; }
DI float bf2f(u16 v) { return __uint_as_float(((u32)v) << 16); }
DI u32 pk2(float a, float b) {
  f32x2 v = {a, b};
  bf16x2 r = __builtin_convertvector(v, bf16x2);
  return __builtin_bit_cast(u32, r);
}
DI float bflo(u32 v) { return __uint_as_float(v << 16); }
DI float bfhi(u32 v) { return __uint_as_float(v & 0xffff0000u); }
DI float siluf(float v) { return v * __builtin_amdgcn_rcpf(1.f + __expf(-v)); }
DI float sigmf(float v) { return __builtin_amdgcn_rcpf(1.f + __expf(-v)); }
DI int otid() {
  int t = __builtin_amdgcn_workitem_id_x();
  asm volatile("" : "+v"(t));
  return t;
}
DI char* ows(char* w) {
  u64 v = (u64)(uintptr_t)w;
  asm volatile("" : "+s"(v));
  return (char*)(__attribute__((address_space(1))) char*)v;
}
DI int crow(int i, int h) { return (i & 3) + 8 * (i >> 2) + 4 * h; }
DI void zero16(f32x16& a) {
#pragma unroll
  for (int i = 0; i < 16; ++i) a[i] = 0.f;
}

DI int next_item(int* ctr, int* s_item) {
  __syncthreads();
  if (otid() == 0) *s_item = atomicAdd(ctr, 1);
  __syncthreads();
  return *s_item;
}

DI void tt_load(f32x4 (&v)[8], const float* __restrict__ src, int lds, int col0, int nvalid, int k0) {
  const int tid = otid();
  const int n4 = (tid & 15) * 4;
#pragma unroll
  for (int i = 0; i < 8; ++i) {
    const int k = (tid >> 4) + 16 * i;
    v[i] = mkf4(0.f, 0.f, 0.f, 0.f);
    if (n4 < nvalid) v[i] = *(const f32x4*)(src + (size_t)(k0 + k) * lds + col0 + n4);
  }
}
DI void tt_store(const f32x4 (&v)[8], u16* __restrict__ dst, int K, int n0, int k0, float* sm) {
  const int tid = otid();
  __syncthreads();
  {
    const int n4 = (tid & 15) * 4;
#pragma unroll
    for (int i = 0; i < 8; ++i) {
      const int k = (tid >> 4) + 16 * i;
      sm[k * 65 + n4 + 0] = v[i].x;
      sm[k * 65 + n4 + 1] = v[i].y;
      sm[k * 65 + n4 + 2] = v[i].z;
      sm[k * 65 + n4 + 3] = v[i].w;
    }
  }
  __syncthreads();
  {
    const int n = tid >> 2, ks = (tid & 3) * 32;
    u32x4* d = (u32x4*)(dst + (size_t)(n0 + n) * K + k0 + ks);
#pragma unroll
    for (int q = 0; q < 4; ++q) {
      u32 o[4];
#pragma unroll
      for (int j = 0; j < 4; ++j)
        o[j] = pk2(sm[(ks + 8 * q + 2 * j) * 65 + n], sm[(ks + 8 * q + 2 * j + 1) * 65 + n]);
      d[q] = mku4(o[0], o[1], o[2], o[3]);
    }
  }
}
DI void transpose_tile(const float* __restrict__ src, int lds, int col0, int nvalid, u16* __restrict__ dst, int K,
                       int n0, int k0, float* sm) {
  f32x4 v[8];
  tt_load(v, src, lds, col0, nvalid, k0);
  tt_store(v, dst, K, n0, k0, sm);
}

DI void rmsnorm_row(const float* __restrict__ src, const float* __restrict__ gain, u16* __restrict__ dst) {
  const int lane = otid() & 63;
  f32x4 v[8];
  float ss = 0.f;
#pragma unroll
  for (int i = 0; i < 8; ++i) {
    v[i] = *(const f32x4*)(src + (i * 64 + lane) * 4);
    ss += v[i].x * v[i].x + v[i].y * v[i].y + v[i].z * v[i].z + v[i].w * v[i].w;
  }
#pragma unroll
  for (int o = 32; o >= 1; o >>= 1) ss += __shfl_xor(ss, o);
  const float rinv = rsqrtf(ss * (1.f / 2048.f) + EPS);
#pragma unroll
  for (int i = 0; i < 8; ++i) {
    const f32x4 g = *(const f32x4*)(gain + (i * 64 + lane) * 4);
    u32x2 o;
    o.x = pk2(v[i].x * rinv * g.x, v[i].y * rinv * g.y);
    o.y = pk2(v[i].z * rinv * g.z, v[i].w * rinv * g.w);
    *(u32x2*)(dst + (i * 64 + lane) * 4) = o;
  }
}

DI void rmsnorm_row2(const float* __restrict__ src0, const float* __restrict__ src1, const float* __restrict__ gain,
                     u16* __restrict__ dst0, u16* __restrict__ dst1) {
  const int lane = otid() & 63;
  f32x4 v[8], u[8];
#pragma unroll
  for (int i = 0; i < 8; ++i) {
    v[i] = *(const f32x4*)(src0 + (i * 64 + lane) * 4);
    u[i] = *(const f32x4*)(src1 + (i * 64 + lane) * 4);
  }
  float ss = 0.f, st = 0.f;
#pragma unroll
  for (int i = 0; i < 8; ++i) {
    ss += v[i].x * v[i].x + v[i].y * v[i].y + v[i].z * v[i].z + v[i].w * v[i].w;
    st += u[i].x * u[i].x + u[i].y * u[i].y + u[i].z * u[i].z + u[i].w * u[i].w;
  }
#pragma unroll
  for (int o = 32; o >= 1; o >>= 1) {
    ss += __shfl_xor(ss, o);
    st += __shfl_xor(st, o);
  }
  const float rv = rsqrtf(ss * (1.f / 2048.f) + EPS), ru = rsqrtf(st * (1.f / 2048.f) + EPS);
#pragma unroll
  for (int i = 0; i < 8; ++i) {
    const f32x4 g = *(const f32x4*)(gain + (i * 64 + lane) * 4);
    u32x2 o;
    o.x = pk2(v[i].x * rv * g.x, v[i].y * rv * g.y);
    o.y = pk2(v[i].z * rv * g.z, v[i].w * rv * g.w);
    *(u32x2*)(dst0 + (i * 64 + lane) * 4) = o;
    o.x = pk2(u[i].x * ru * g.x, u[i].y * ru * g.y);
    o.y = pk2(u[i].z * ru * g.z, u[i].w * ru * g.w);
    *(u32x2*)(dst1 + (i * 64 + lane) * 4) = o;
  }
}
DI int even_src(int nt, int& valid) {
  valid = (nt == 20) ? 24 : 128;
  return nt <= 20 ? 128 * nt : 2584 + 128 * (nt - 21);
}
DI int odd_src(int nt, int& valid) {
  valid = (nt == 28) ? 80 : 128;
  return nt <= 28 ? 128 * nt : 3664 + 128 * (nt - 29);
}

DI void phase_prep(const Params& p, int layer, char* smem) {
  const int tid = otid(), G = gridDim.x, bid = blockIdx.x;
  const int par = layer & 1, e = layer >> 1;
  char* ws = ows(p.ws);
  float* sm = (float*)smem;
  const int gw = bid * 4 + (tid >> 6), nw = G * 4;
  {
    const float* xin = layer == 0 ? p.x : p.out;
    u16* hy = (u16*)(ws + OFF_HY);
    for (int row = gw; row < NTOK; row += 2 * nw) {
      const int row1 = row + nw;
      if (row1 < NTOK)
        rmsnorm_row2(xin + (size_t)row * DM, xin + (size_t)row1 * DM, p.norm_gain + layer * DM, hy + (size_t)row * DM,
                     hy + (size_t)row1 * DM);
      else
        rmsnorm_row(xin + (size_t)row * DM, p.norm_gain + layer * DM, hy + (size_t)row * DM);
    }
  }
  {
    u16* wtin = (u16*)(ws + OFF_WTIN);
    const int ntl = par ? ODD_NT : EVEN_NT;
    const float* win = par ? p.odd_w_in + (size_t)e * DM * ODD_IN : p.even_w_in + (size_t)e * DM * EVEN_IN;
    const int ldw = par ? ODD_IN : EVEN_IN;
    const int ntiles = ntl * 2 * 16;
    auto issue = [&](int it, f32x4(&vv)[8]) __attribute__((always_inline)) {
      const int kt = it & 15, n64 = it >> 4;
      int valid;
      const int sb = par ? odd_src(n64 >> 1, valid) : even_src(n64 >> 1, valid);
      const int half = n64 & 1;
      int nv = valid - 64 * half;
      nv = nv < 0 ? 0 : (nv > 64 ? 64 : nv);
      tt_load(vv, win, ldw, sb + 64 * half, nv, kt * 128);
    };
    f32x4 va[8];
    int it = bid;
    if (it < ntiles) issue(it, va);
    while (it < ntiles) {
      const int itn = it + G;
      f32x4 vb[8];
      if (itn < ntiles) issue(itn, vb);
      tt_store(va, wtin, DM, (it >> 4) * 64, (it & 15) * 128, sm);
#pragma unroll
      for (int i = 0; i < 8; ++i) va[i] = vb[i];
      it = itn;
    }
    u16* wtout = (u16*)(ws + OFF_WTOUT);
    const float* wo = p.w_out + (size_t)layer * DM * DM;
    for (int it = bid; it < 32 * 16; it += G)
      transpose_tile(wo, DM, (it >> 4) * 64, 64, wtout, DM, (it >> 4) * 64, (it & 15) * 128, sm);
  }
  if (!par) {
    u16* w1t = (u16*)(ws + OFF_W1T);
    for (int it = bid; it < 2 * 4 * 32; it += G) {
      const int kv = it >> 7, n64 = (it >> 5) & 3, kt = it & 31;
      transpose_tile(p.nsa_cmp_w1 + ((size_t)(e * 2 + kv)) * 4096 * 256, 256, n64 * 64, 64,
                     w1t + (size_t)kv * 256 * 4096, 4096, n64 * 64, kt * 128, sm);
    }
    u16* w2t = (u16*)(ws + OFF_W2T);
    for (int it = bid; it < 2 * 2 * 2; it += G) {
      const int kv = it >> 2, n64 = (it >> 1) & 1, kt = it & 1;
      transpose_tile(p.nsa_cmp_w2 + ((size_t)(e * 2 + kv)) * 256 * 128, 128, n64 * 64, 64, w2t + (size_t)kv * 128 * 256,
                     256, n64 * 64, kt * 128, sm);
    }
    float* cbp = (float*)(ws + OFF_CBPART);
    for (int it = bid; it < 128; it += G) {
      const int kv = it >> 6, chk = it & 63;
      const float* pe = p.nsa_cmp_pos + (size_t)(e * 2 + kv) * 4096 + chk * 64;
      const float* w1 = p.nsa_cmp_w1 + ((size_t)(e * 2 + kv)) * 4096 * 256 + (size_t)chk * 64 * 256;
      float a = 0.f;
#pragma unroll 16
      for (int f = 0; f < 64; ++f) a += pe[f] * w1[(size_t)f * 256 + tid];
      cbp[it * 256 + tid] = a;
    }
    if (bid == G - 1 && tid == 0) {
      const float* lv = p.diff_lambda + (size_t)e * 4 * 64;
      float s0 = 0.f, s1 = 0.f;
      for (int i = 0; i < 64; ++i) {
        s0 += lv[i] * lv[64 + i];
        s1 += lv[128 + i] * lv[192 + i];
      }
      ((float*)(ws + OFF_MISC))[e] = expf(s0) - expf(s1);
    }
  }
}

DI void phase_prep0_extra(const Params& p, char* smem) {
  const int tid = otid(), G = gridDim.x, bid = blockIdx.x;
  char* ws = ows(p.ws);
  float* sm = (float*)smem;
  const int gw = bid * 4 + (tid >> 6), nw = G * 4;
    float* c64 = (float*)(ws + OFF_COS64);
    float* s64 = (float*)(ws + OFF_SIN64);
    float* c32 = (float*)(ws + OFF_COS32);
    float* s32 = (float*)(ws + OFF_SIN32);
    for (int idx = bid * NTHREADS + tid; idx < SEQ * 64; idx += G * NTHREADS) {
      const int t = idx >> 6, i = idx & 63;
      const float inv = powf(10000.f, -(float)i / 64.f);
      const float ang = (float)t * inv;
      c64[idx] = cosf(ang);
      s64[idx] = sinf(ang);
      if (i < 32) {
        const float inv2 = powf(10000.f, -(float)i / 32.f);
        const float a2 = (float)t * inv2;
        c32[t * 32 + i] = cosf(a2);
        s32[t * 32 + i] = sinf(a2);
      }
    }
    u16* memn = (u16*)(ws + OFF_MEMN);
    for (int row = gw; row < NB * 256; row += nw)
      rmsnorm_row(p.mem + (size_t)row * DM, p.mem_norm_gain, memn + (size_t)row * DM);
    u16* wkvt = (u16*)(ws + OFF_WKVT);
    for (int it = bid; it < 4 * 16 * 16; it += G) {
      const int li = it >> 8, n64 = (it >> 4) & 15, kt = it & 15;
      transpose_tile(p.mem_w_kv + (size_t)li * DM * 1024, 1024, n64 * 64, 64, wkvt + (size_t)li * 1024 * DM, DM, n64 * 64,
                     kt * 128, sm);
    }
}

constexpr int GAIN_OFF = (256 + 128) * 72 * 2;
template <bool USTRIDE, class RowF, class EpiF>
DI void gemm_block(const u16* __restrict__ abase, RowF rowoff, int ldk2, const u16* __restrict__ Wt, int K, int m0, int n0,
                   char* smem, EpiF epi, const float* __restrict__ gsrc = nullptr, int gmask = 127) {
  u16* As = (u16*)smem;
  u16* Ws = As + 256 * 72;
  const int tid = otid(), lane = tid & 63, w = tid >> 6, r = lane & 31, h = lane >> 5;
  if (gsrc) {
    __syncthreads();
    if (tid < 128) ((float*)(smem + GAIN_OFF))[tid] = gsrc[tid & gmask];
  }
  f32x16 acc[2][4];
#pragma unroll
  for (int g = 0; g < 2; ++g)
#pragma unroll
    for (int i = 0; i < 4; ++i) zero16(acc[g][i]);
  const int kc = (tid & 7) * 8;
  u32 ao[8];
  if (USTRIDE) {
    ao[0] = rowoff(m0 + (tid >> 3));
    const u32 st32 = rowoff(32) - rowoff(0);
#pragma unroll
    for (int i = 1; i < 8; ++i) ao[i] = ao[0] + st32 * i;
  } else {
#pragma unroll
    for (int i = 0; i < 8; ++i) ao[i] = rowoff(m0 + (tid >> 3) + 32 * i);
  }
  const u16* wp0 = Wt + (size_t)(n0 + (tid >> 3)) * K + kc;
  const size_t wstep = (size_t)32 * K;
  const int lo = (tid >> 3) * 72 + kc;
  u32x4 ra[8], rw[4];
  {
    const int off = (kc >> 7) * ldk2 + (kc & 127);
#pragma unroll
    for (int i = 0; i < 8; ++i) ra[i] = *(const u32x4*)(abase + ao[i] + off);
#pragma unroll
    for (int i = 0; i < 4; ++i) rw[i] = *(const u32x4*)(wp0 + wstep * i);
  }
  for (int k0 = 0; k0 < K; k0 += 64) {
    __syncthreads();
#pragma unroll
    for (int i = 0; i < 8; ++i) *(u32x4*)(As + lo + 32 * 72 * i) = ra[i];
#pragma unroll
    for (int i = 0; i < 4; ++i) *(u32x4*)(Ws + lo + 32 * 72 * i) = rw[i];
    __syncthreads();
    if (k0 + 64 < K) {
      const int k = k0 + 64 + kc;
      const int off = (k >> 7) * ldk2 + (k & 127);
#pragma unroll
      for (int i = 0; i < 8; ++i) ra[i] = *(const u32x4*)(abase + ao[i] + off);
#pragma unroll
      for (int i = 0; i < 4; ++i) rw[i] = *(const u32x4*)(wp0 + wstep * i + k0 + 64);
    }
    __builtin_amdgcn_s_setprio(1);
#pragma unroll
    for (int s = 0; s < 4; ++s) {
      const bf16x8 b0 = *(const bf16x8*)(As + (64 * w + r) * 72 + 16 * s + 8 * h);
      const bf16x8 b1 = *(const bf16x8*)(As + (64 * w + 32 + r) * 72 + 16 * s + 8 * h);
#pragma unroll
      for (int nt = 0; nt < 4; ++nt) {
        const bf16x8 a = *(const bf16x8*)(Ws + (32 * nt + r) * 72 + 16 * s + 8 * h);
        acc[0][nt] = MFMA32(a, b0, acc[0][nt]);
        acc[1][nt] = MFMA32(a, b1, acc[1][nt]);
      }
    }
    __builtin_amdgcn_s_setprio(0);
  }
  __syncthreads();
  const int tok0 = __builtin_amdgcn_readfirstlane(m0 + 64 * w);
  epi(acc[0], tok0 + r, h, tok0);
  epi(acc[1], tok0 + 32 + r, h, tok0 + 32);
}

DI void norm128(f32x16 (&acc)[4], const float* gain, int h) {
  float ss = 0.f;
#pragma unroll
  for (int nt = 0; nt < 4; ++nt)
#pragma unroll
    for (int i = 0; i < 16; ++i) ss += acc[nt][i] * acc[nt][i];
  ss += __shfl_xor(ss, 32);
  const float rinv = rsqrtf(ss * (1.f / 128.f) + EPS);
#pragma unroll
  for (int nt = 0; nt < 4; ++nt) {
#pragma unroll
    for (int ig = 0; ig < 4; ++ig) {
      const f32x4 g = *(const f32x4*)(gain + 32 * nt + 8 * ig + 4 * h);
      acc[nt][4 * ig + 0] *= rinv * g.x;
      acc[nt][4 * ig + 1] *= rinv * g.y;
      acc[nt][4 * ig + 2] *= rinv * g.z;
      acc[nt][4 * ig + 3] *= rinv * g.w;
      if (ig & 1) __builtin_amdgcn_sched_barrier(0);
    }
  }
}
DI void norm64(f32x16 (&acc)[4], const float* gain, int h) {
  float rinv[2];
#pragma unroll
  for (int pp = 0; pp < 2; ++pp) {
    float ss = 0.f;
#pragma unroll
    for (int q = 0; q < 2; ++q)
#pragma unroll
      for (int i = 0; i < 16; ++i) ss += acc[2 * pp + q][i] * acc[2 * pp + q][i];
    ss += __shfl_xor(ss, 32);
    rinv[pp] = rsqrtf(ss * (1.f / 64.f) + EPS);
  }
#pragma unroll
  for (int q = 0; q < 2; ++q) {
#pragma unroll
    for (int ig = 0; ig < 4; ++ig) {
      const f32x4 g = *(const f32x4*)(gain + 32 * q + 8 * ig + 4 * h);
#pragma unroll
      for (int pp = 0; pp < 2; ++pp) {
        acc[2 * pp + q][4 * ig + 0] *= rinv[pp] * g.x;
        acc[2 * pp + q][4 * ig + 1] *= rinv[pp] * g.y;
        acc[2 * pp + q][4 * ig + 2] *= rinv[pp] * g.z;
        acc[2 * pp + q][4 * ig + 3] *= rinv[pp] * g.w;
      }
    }
    __builtin_amdgcn_sched_barrier(0);
  }
}
struct RopeTab128 {
  f32x4 c[4], s[4];
};
DI void rope128_load(RopeTab128& tb, int nt, const float* __restrict__ c64, const float* __restrict__ s64, int t, int h) {
#pragma unroll
  for (int ig = 0; ig < 4; ++ig) {
    const int d1 = 32 * nt + 8 * ig + 4 * h;
    tb.c[ig] = *(const f32x4*)(c64 + t * 64 + d1);
    tb.s[ig] = *(const f32x4*)(s64 + t * 64 + d1);
  }
}
DI void rope128_apply(f32x16 (&acc)[4], int nt, const RopeTab128& tb) {
#pragma unroll
  for (int ig = 0; ig < 4; ++ig)
#pragma unroll
    for (int q = 0; q < 4; ++q) {
      const int i = 4 * ig + q;
      const float c = tb.c[ig][q], sn = tb.s[ig][q];
      const float x1 = acc[nt][i], x2 = acc[nt + 2][i];
      acc[nt][i] = x1 * c - x2 * sn;
      acc[nt + 2][i] = x2 * c + x1 * sn;
    }
}
template <bool EARLY = true>
DI void norm_rope128(f32x16 (&acc)[4], const float* gl, const float* __restrict__ c64, const float* __restrict__ s64, int t, int h) {
  if (EARLY) {
    RopeTab128 tb;
    rope128_load(tb, 0, c64, s64, t, h);
    norm128(acc, gl, h);
    rope128_apply(acc, 0, tb);
    __builtin_amdgcn_sched_barrier(0);
    rope128_load(tb, 1, c64, s64, t, h);
    rope128_apply(acc, 1, tb);
  } else {
    norm128(acc, gl, h);
    __builtin_amdgcn_sched_barrier(0);
#pragma unroll
    for (int nt = 0; nt < 2; ++nt)
#pragma unroll
      for (int hb = 0; hb < 2; ++hb) {
        f32x4 c[2], sn[2];
#pragma unroll
        for (int k = 0; k < 2; ++k) {
          const int d1 = 32 * nt + 8 * (2 * hb + k) + 4 * h;
          c[k] = *(const f32x4*)(c64 + t * 64 + d1);
          sn[k] = *(const f32x4*)(s64 + t * 64 + d1);
        }
#pragma unroll
        for (int k = 0; k < 2; ++k)
#pragma unroll
          for (int q = 0; q < 4; ++q) {
            const int i = 4 * (2 * hb + k) + q;
            const float x1 = acc[nt][i], x2 = acc[nt + 2][i];
            acc[nt][i] = x1 * c[k][q] - x2 * sn[k][q];
            acc[nt + 2][i] = x2 * c[k][q] + x1 * sn[k][q];
          }
        __builtin_amdgcn_sched_barrier(0);
      }
  }
}
struct RopeTab64 {
  f32x4 c[4], s[4];
};
DI void rope64_load(RopeTab64& tb, const float* __restrict__ c32, const float* __restrict__ s32, int t, int h) {
#pragma unroll
  for (int ig = 0; ig < 4; ++ig) {
    const int d1 = 8 * ig + 4 * h;
    tb.c[ig] = *(const f32x4*)(c32 + t * 32 + d1);
    tb.s[ig] = *(const f32x4*)(s32 + t * 32 + d1);
  }
}
DI void rope64_apply(f32x16 (&acc)[4], int pp, const RopeTab64& tb) {
#pragma unroll
  for (int ig = 0; ig < 4; ++ig)
#pragma unroll
    for (int q = 0; q < 4; ++q) {
      const int i = 4 * ig + q;
      const float c = tb.c[ig][q], sn = tb.s[ig][q];
      const float x1 = acc[2 * pp][i], x2 = acc[2 * pp + 1][i];
      acc[2 * pp][i] = x1 * c - x2 * sn;
      acc[2 * pp + 1][i] = x2 * c + x1 * sn;
    }
}
DI void store_plain(const f32x16 (&acc)[4], u16* __restrict__ rowbase, int h) {
#pragma unroll
  for (int nt = 0; nt < 4; ++nt)
#pragma unroll
    for (int ig = 0; ig < 4; ++ig) {
      u32x2 o;
      o.x = pk2(acc[nt][4 * ig], acc[nt][4 * ig + 1]);
      o.y = pk2(acc[nt][4 * ig + 2], acc[nt][4 * ig + 3]);
      *(u32x2*)(rowbase + 32 * nt + 8 * ig + 4 * h) = o;
    }
}
constexpr int WB_LD = 136;
DI void store_rows(const f32x16 (&acc)[4], u16* __restrict__ base0, int ld, char* smem, int h) {
  const int tid = otid(), lane = tid & 63, w = tid >> 6, r = lane & 31;
  u16* wb = (u16*)smem + w * (32 * WB_LD);
#pragma unroll
  for (int nt = 0; nt < 4; ++nt)
#pragma unroll
    for (int ig = 0; ig < 4; ++ig) {
      u32x2 o;
      o.x = pk2(acc[nt][4 * ig], acc[nt][4 * ig + 1]);
      o.y = pk2(acc[nt][4 * ig + 2], acc[nt][4 * ig + 3]);
      *(u32x2*)(wb + r * WB_LD + 32 * nt + 8 * ig + 4 * h) = o;
    }
  __builtin_amdgcn_fence(__ATOMIC_SEQ_CST, "workgroup");
  __builtin_amdgcn_wave_barrier();
#pragma unroll
  for (int it = 0; it < 8; ++it) {
    const int row = it * 4 + (lane >> 4), ch = lane & 15;
    const u32x4 v = *(const u32x4*)(wb + row * WB_LD + ch * 8);
    *(u32x4*)(base0 + (size_t)row * ld + ch * 8) = v;
    if (it & 1) __builtin_amdgcn_sched_barrier(0);
  }
  __builtin_amdgcn_fence(__ATOMIC_SEQ_CST, "workgroup");
  __builtin_amdgcn_wave_barrier();
}
DI void store_vt(const f32x16 (&acc)[4], u16* __restrict__ base, size_t ld, int h) {
#pragma unroll
  for (int nt = 0; nt < 4; ++nt)
#pragma unroll
    for (int i = 0; i < 16; ++i) base[(size_t)(32 * nt + crow(i, h)) * ld] = f2bf(acc[nt][i]);
}

struct XcdInfo {
  int xi, nx, lrank, nloc;
};
DI void phase_proj(const Params& p, int layer, char* smem, const XcdInfo xc) {
  const int G = gridDim.x, bid = blockIdx.x;
  const int par = layer & 1, e = layer >> 1;
  char* ws = ows(p.ws);
  const u16* hy = (const u16*)(ws + OFF_HY);
  const u16* wtin = (const u16*)(ws + OFF_WTIN);
  const float* c64 = (const float*)(ws + OFF_COS64);
  const float* s64 = (const float*)(ws + OFF_SIN64);
  const float* c32 = (const float*)(ws + OFF_COS32);
  const float* s32 = (const float*)(ws + OFF_SIN32);
  u16* zb = (u16*)(ws + OFF_Z);
  if (!par && bid == G - 1) {
    const int tid = otid();
    const float* cbp = (const float*)(ws + OFF_CBPART);
    float* cb = (float*)(ws + OFF_CBIAS);
#pragma unroll
    for (int kv = 0; kv < 2; ++kv) {
      float a = 0.f;
#pragma unroll 16
      for (int c = 0; c < 64; ++c) a += cbp[(kv * 64 + c) * 256 + tid];
      cb[kv * 256 + tid] = a;
    }
  }
  const int ntl = par ? ODD_NT : EVEN_NT;
  const int ntiles = ntl * 64;
  const int mcount = (64 - xc.xi + xc.nx - 1) / xc.nx;
  const int nslots = ((mcount + 1) >> 1) * 2 * ntl;
  (void)ntiles;
  for (int it = xc.lrank; it < nslots; it += xc.nloc) {
    const int grp = it / (2 * ntl), rem = it - grp * 2 * ntl;
    const int nt = rem >> 1, ml = 2 * grp + (rem & 1);
    if (ml >= mcount) continue;
    const int mt = xc.xi + ml * xc.nx;
    auto rowp = [&](int m) __attribute__((always_inline)) { return (u32)m * (u32)DM; };
    const float* gsrc = nullptr;
    if (!par) {
      if (nt < 8) gsrc = p.nsa_qk_gain + (e * 4 + 0) * 128;
      else if (nt >= 12 && nt < 14) gsrc = p.nsa_qk_gain + (e * 4 + 2) * 128;
      else if (nt >= 16 && nt < 18) gsrc = p.nsa_qk_gain + (e * 4 + 3) * 128;
      else if (nt >= 29 && nt < 33) gsrc = p.diff_qk_gain + (e * 2 + 0) * 64;
      else if (nt >= 33 && nt < 37) gsrc = p.diff_qk_gain + (e * 2 + 1) * 64;
      else if (nt >= 45 && nt < 49) gsrc = p.mem_qk_gain + (layer * 2 + 0) * 128;
    } else {
      if (nt < 12) gsrc = p.dsa_qk_gain + (e * 2 + 0) * 128;
      else if (nt < 16) gsrc = p.dsa_qk_gain + (e * 2 + 1) * 128;
      else if (nt >= 41 && nt < 45) gsrc = p.mem_qk_gain + (layer * 2 + 0) * 128;
    }
    const float* gl = (const float*)(smem + GAIN_OFF);
    auto epi = [&](f32x16(&acc)[4], int tok, int h, int tok0) __attribute__((always_inline)) {
      const int t = tok & (SEQ - 1), b = tok >> 13;
      char* ws = ows(p.ws);
      u16* zb = (u16*)(ws + OFF_Z);
      if (!par) {
        if (nt < 8) {
          norm_rope128<false>(acc, gl, c64, s64, t, h);
          store_rows(acc, (u16*)(ws + E_QA) + (size_t)tok0 * 1024 + 128 * nt, 1024, smem, h);
        } else if (nt < 20) {
          const int j = (nt - 8) >> 1, g = (nt - 8) & 1;
          if (j == 0) store_rows(acc, (u16*)(ws + E_KCRAW) + (size_t)tok0 * 256 + g * 128, 256, smem, h);
          else if (j == 1) store_rows(acc, (u16*)(ws + E_VCRAW) + (size_t)tok0 * 256 + g * 128, 256, smem, h);
          else if (j == 2) {
            norm_rope128<false>(acc, gl, c64, s64, t, h);
            store_rows(acc, (u16*)(ws + E_KS) + (size_t)tok0 * 256 + g * 128, 256, smem, h);
          } else if (j == 3) store_vt(acc, (u16*)(ws + E_VST) + (size_t)((b * 2 + g) * 128) * SEQ + t, SEQ, h);
          else if (j == 4) {
            norm_rope128<false>(acc, gl, c64, s64, t, h);
            store_rows(acc, (u16*)(ws + E_KW) + (size_t)tok0 * 256 + g * 128, 256, smem, h);
          } else store_vt(acc, (u16*)(ws + E_VWT) + (size_t)((b * 2 + g) * 128) * SEQ + t, SEQ, h);
        } else if (nt == 20) {
          float* ag = (float*)(ws + E_AG) + (size_t)tok * 32;
#pragma unroll
          for (int ig = 0; ig < 3; ++ig)
            *(f32x4*)(ag + 8 * ig + 4 * h) =
                mkf4(acc[0][4 * ig], acc[0][4 * ig + 1], acc[0][4 * ig + 2], acc[0][4 * ig + 3]);
        } else if (nt < 29) store_rows(acc, zb + (size_t)tok0 * DM + 128 * (nt - 21), DM, smem, h);
        else if (nt < 37) {
          const int isk = nt >= 33;
          RopeTab64 tb;
          rope64_load(tb, c32, s32, t, h);
          norm64(acc, gl, h);
          rope64_apply(acc, 0, tb);
          rope64_apply(acc, 1, tb);
          store_rows(acc, (u16*)(ws + (isk ? E_BK : E_BQ)) + (size_t)tok0 * 512 + 128 * (isk ? nt - 33 : nt - 29), 512, smem, h);
        } else if (nt < 41) store_vt(acc, (u16*)(ws + E_BVT) + (size_t)((b * 4 + (nt - 37)) * 128) * SEQ + t, SEQ, h);
        else if (nt < 45) store_rows(acc, zb + (size_t)tok0 * DM + 1024 + 128 * (nt - 41), DM, smem, h);
        else if (nt < 49) {
          norm128(acc, gl, h);
          store_rows(acc, (u16*)(ws + E_MQ) + (size_t)tok0 * 512 + 128 * (nt - 45), 512, smem, h);
        } else store_rows(acc, zb + (size_t)tok0 * DM + 1536 + 128 * (nt - 49), DM, smem, h);
      } else {
        if (nt < 12) {
          norm_rope128<false>(acc, gl, c64, s64, t, h);
          store_rows(acc, (u16*)(ws + O_CQ) + (size_t)tok0 * 1536 + 128 * nt, 1536, smem, h);
        } else if (nt < 16) {
          norm_rope128<false>(acc, gl, c64, s64, t, h);
          store_rows(acc, (u16*)(ws + O_CK) + (size_t)tok0 * 512 + 128 * (nt - 12), 512, smem, h);
        } else if (nt < 20) store_vt(acc, (u16*)(ws + O_CVT) + (size_t)((b * 4 + (nt - 16)) * 128) * SEQ + t, SEQ, h);
        else if (nt < 28) {
          RopeTab64 tb;
          rope64_load(tb, c32, s32, t, h);
          rope64_apply(acc, 0, tb);
          rope64_apply(acc, 1, tb);
          store_rows(acc, (u16*)(ws + O_IQ) + (size_t)tok0 * 1024 + 128 * (nt - 20), 1024, smem, h);
        } else if (nt == 28) {
          RopeTab64 tb;
          rope64_load(tb, c32, s32, t, h);
          rope64_apply(acc, 0, tb);
          u16* ik = (u16*)(ws + O_IK) + (size_t)tok * 64;
#pragma unroll
          for (int q = 0; q < 2; ++q)
#pragma unroll
            for (int ig = 0; ig < 4; ++ig) {
              u32x2 o;
              o.x = pk2(acc[q][4 * ig], acc[q][4 * ig + 1]);
              o.y = pk2(acc[q][4 * ig + 2], acc[q][4 * ig + 3]);
              *(u32x2*)(ik + 32 * q + 8 * ig + 4 * h) = o;
            }
          float* iw = (float*)(ws + O_IW) + (size_t)tok * 16;
#pragma unroll
          for (int ig = 0; ig < 2; ++ig)
            *(f32x4*)(iw + 8 * ig + 4 * h) = mkf4(acc[2][4 * ig] * 0.03125f, acc[2][4 * ig + 1] * 0.03125f,
                                                          acc[2][4 * ig + 2] * 0.03125f, acc[2][4 * ig + 3] * 0.03125f);
        } else if (nt < 41) store_rows(acc, zb + (size_t)tok0 * DM + 128 * (nt - 29), DM, smem, h);
        else if (nt < 45) {
          norm128(acc, gl, h);
          store_rows(acc, (u16*)(ws + O_MQ) + (size_t)tok0 * 512 + 128 * (nt - 41), 512, smem, h);
        } else store_rows(acc, zb + (size_t)tok0 * DM + 1536 + 128 * (nt - 45), DM, smem, h);
      }
    };
    gemm_block<true>(hy, rowp, 128, wtin, DM, mt * 256, nt * 128, smem, epi, gsrc, (!par && nt >= 29 && nt < 37) ? 63 : 127);
  }
  if (layer == 0) {
    const u16* memn = (const u16*)(ws + OFF_MEMN);
    for (int it = bid; it < 4 * 2 * 8; it += G) {
      const int li = it >> 4, mt = (it >> 3) & 1, nt = it & 7;
      const u16* wt = (const u16*)(ws + OFF_WKVT) + (size_t)li * 1024 * DM;
      auto rowp = [&](int m) __attribute__((always_inline)) { return (u32)m * (u32)DM; };
      auto epi = [&](f32x16(&acc)[4], int row, int h, int tok0) __attribute__((always_inline)) {
        const int b = row >> 8, slot = row & 255;
        if (nt < 4) {
          norm128(acc, (const float*)(smem + GAIN_OFF), h);
          store_plain(acc, (u16*)(ws + OFF_MEMK) + ((size_t)li * 512 + row) * 512 + nt * 128, h);
        } else {
          store_vt(acc, (u16*)(ws + OFF_MEMVT) + (size_t)(((li * 2 + b) * 4 + (nt - 4)) * 128) * 256 + slot, 256, h);
        }
      };
      gemm_block<true>(memn, rowp, 128, wt, DM, mt * 256, nt * 128, smem, epi, nt < 4 ? p.mem_qk_gain + (li * 2 + 1) * 128 : nullptr);
    }
  }
}

DI void phase_outproj(const Params& p, int layer, char* smem, const XcdInfo xc) {
  const int G = gridDim.x, bid = blockIdx.x;
  const u16* y = (const u16*)(ows(p.ws) + OFF_HY);
  const u16* wt = (const u16*)(ows(p.ws) + OFF_WTOUT);
  const float* xin = (const float*)ows((char*)(layer == 0 ? p.x : p.out));
  float* xo = (float*)ows((char*)p.out);
  const int mcount = (64 - xc.xi + xc.nx - 1) / xc.nx;
  const int nslots = ((mcount + 1) >> 1) * 2 * 16;
  for (int it = xc.lrank; it < nslots; it += xc.nloc) {
    const int grp = it >> 5, rem = it & 31;
    const int nt = rem >> 1, ml = 2 * grp + (rem & 1);
    if (ml >= mcount) continue;
    const int mt = xc.xi + ml * xc.nx;
    auto rowp = [&](int m) __attribute__((always_inline)) { return (u32)m * (u32)DM; };
    auto epi = [&](f32x16(&acc)[4], int tok, int h, int tok0) __attribute__((always_inline)) {
      const int tid = otid(), lane = tid & 63, w = tid >> 6, r = lane & 31;
      float* wb = (float*)smem + w * (32 * 132);
#pragma unroll
      for (int q = 0; q < 4; ++q)
#pragma unroll
        for (int ig = 0; ig < 4; ++ig)
          *(f32x4*)(wb + r * 132 + 32 * q + 8 * ig + 4 * h) =
              mkf4(acc[q][4 * ig], acc[q][4 * ig + 1], acc[q][4 * ig + 2], acc[q][4 * ig + 3]);
      __builtin_amdgcn_fence(__ATOMIC_SEQ_CST, "workgroup");
      __builtin_amdgcn_wave_barrier();
      const size_t o0 = (size_t)tok0 * DM + nt * 128 + (lane & 31) * 4;
#pragma unroll
      for (int hb = 0; hb < 4; ++hb) {
        f32x4 xv[4];
#pragma unroll
        for (int k = 0; k < 4; ++k) {
          const int row = (4 * hb + k) * 2 + (lane >> 5);
          xv[k] = *(const f32x4*)(xin + o0 + (size_t)row * DM);
        }
#pragma unroll
        for (int k = 0; k < 4; ++k) {
          const int row = (4 * hb + k) * 2 + (lane >> 5);
          const f32x4 a = *(const f32x4*)(wb + row * 132 + (lane & 31) * 4);
          *(f32x4*)(xo + o0 + (size_t)row * DM) = xv[k] + a;
        }
      }
      __builtin_amdgcn_fence(__ATOMIC_SEQ_CST, "workgroup");
      __builtin_amdgcn_wave_barrier();
    };
    gemm_block<true>(y, rowp, 128, wt, DM, mt * 256, nt * 128, smem, epi);
  }
}

DI void cmp_rowdec(int m, int& b, int& c, int& g) {
  const int mm = m < 2044 ? m : 0;
  b = mm / 1022;
  const int rem = mm - b * 1022;
  c = rem >> 1;
  g = rem & 1;
}
DI void mlp1_tiles(const Params& p, char* smem) {
  const int G = gridDim.x, bid = blockIdx.x;
  char* ws = ows(p.ws);
  for (int it = bid; it < 32; it += G) {
    const int kv = it >> 4, mt = (it >> 1) & 7, nt = it & 1;
    const u16* raw = (const u16*)(ws + (kv ? E_VCRAW : E_KCRAW));
    const u16* wt = (const u16*)(ws + OFF_W1T) + (size_t)kv * 256 * 4096;
    const float* cb = (const float*)(ws + OFF_CBIAS) + kv * 256 + nt * 128;
    u16* hid = (u16*)(ws + E_HID) + (size_t)kv * 2048 * 256;
    auto rowp = [&](int m) __attribute__((always_inline)) {
      int b, c, g;
      cmp_rowdec(m, b, c, g);
      return (u32)((b * SEQ + 16 * c) * 256 + g * 128);
    };
    auto epi = [&](f32x16(&acc)[4], int m, int h, int tok0) __attribute__((always_inline)) {
#pragma unroll
      for (int q = 0; q < 4; ++q)
#pragma unroll
        for (int ig = 0; ig < 4; ++ig) {
          const f32x4 bb = *(const f32x4*)(cb + 32 * q + 8 * ig + 4 * h);
          acc[q][4 * ig] = siluf(acc[q][4 * ig] + bb.x);
          acc[q][4 * ig + 1] = siluf(acc[q][4 * ig + 1] + bb.y);
          acc[q][4 * ig + 2] = siluf(acc[q][4 * ig + 2] + bb.z);
          acc[q][4 * ig + 3] = siluf(acc[q][4 * ig + 3] + bb.w);
        }
      store_plain(acc, hid + (size_t)m * 256 + nt * 128, h);
    };
    gemm_block<false>(raw, rowp, 256, wt, 4096, mt * 256, nt * 128, smem, epi);
  }
}
DI void phase_mlp2(const Params& p, int layer, char* smem) {
  const int G = gridDim.x, bid = blockIdx.x;
  const int e = layer >> 1;
  char* ws = ows(p.ws);
  const float* c64 = (const float*)(ws + OFF_COS64);
  const float* s64 = (const float*)(ws + OFF_SIN64);
  for (int it = bid; it < 16; it += G) {
    const int kv = it >> 3, mt = it & 7;
    const u16* hid = (const u16*)(ws + E_HID) + (size_t)kv * 2048 * 256;
    const u16* wt = (const u16*)(ws + OFF_W2T) + (size_t)kv * 128 * 256;
    auto rowp = [&](int m) __attribute__((always_inline)) { return (u32)m * 256u; };
    auto epi = [&](f32x16(&acc)[4], int m, int h, int tok0) __attribute__((always_inline)) {
      int b, c, g;
      cmp_rowdec(m, b, c, g);
      if (m < 2044) {
        if (kv == 0) {
          norm_rope128<false>(acc, (const float*)(smem + GAIN_OFF), c64, s64, 16 * c + 31, h);
          store_plain(acc, (u16*)(ws + E_KC) + ((size_t)(b * 512 + c)) * 256 + g * 128, h);
        } else {
          store_vt(acc, (u16*)(ws + E_VCT) + (size_t)((b * 2 + g) * 128) * 512 + c, 512, h);
        }
      }
    };
    gemm_block<true>(hid, rowp, 128, wt, 256, mt * 256, 0, smem, epi, kv == 0 ? p.nsa_qk_gain + (e * 4 + 1) * 128 : nullptr);
  }
}

struct FS {
  f32x16 O[4];
  float m, l;
};
constexpr int KS_LD = 136, VS_LD = 68;
constexpr int KS_BYTES = 64 * KS_LD * 2, VS_BYTES = 128 * VS_LD * 2;

struct TileRegs {
  u32x4 k[4], v[4];
};
DI void tile_gload_k(TileRegs& tr, const u16* __restrict__ kb, int ldk) {
  const int tid = otid();
#pragma unroll
  for (int i = 0; i < 4; ++i) {
    const int c = tid + 256 * i;
    tr.k[i] = *(const u32x4*)(kb + (size_t)(c >> 4) * ldk + (c & 15) * 8);
  }
}
DI void tile_gload_v(TileRegs& tr, const u16* __restrict__ vb, int ldv) {
  const int tid = otid();
#pragma unroll
  for (int i = 0; i < 4; ++i) {
    const int c = tid + 256 * i;
    tr.v[i] = *(const u32x4*)(vb + (size_t)(c >> 3) * ldv + (c & 7) * 8);
  }
}
DI void tile_sstore_k(const TileRegs& tr, u16* Ks) {
  const int tid = otid();
#pragma unroll
  for (int i = 0; i < 4; ++i) {
    const int c = tid + 256 * i;
    *(u32x4*)(Ks + (c >> 4) * KS_LD + (c & 15) * 8) = tr.k[i];
  }
}
DI void tile_sstore_v(const TileRegs& tr, u16* Vs) {
  const int tid = otid();
#pragma unroll
  for (int i = 0; i < 4; ++i) {
    const int c = tid + 256 * i;
    u32x2* d = (u32x2*)(Vs + (c >> 3) * VS_LD + (c & 7) * 8);
    d[0] = mku2(tr.v[i].x, tr.v[i].y);
    d[1] = mku2(tr.v[i].z, tr.v[i].w);
  }
}

template <int NS>
DI void qk_tile(const u16* Ks, int kcol0, const bf16x8 (&qf)[NS], f32x16 (&S)[2], int r, int h) {
#pragma unroll
  for (int kt = 0; kt < 2; ++kt) {
    zero16(S[kt]);
#pragma unroll
    for (int s = 0; s < NS; ++s) {
      const bf16x8 a = *(const bf16x8*)(Ks + (32 * kt + r) * KS_LD + kcol0 + 16 * s + 8 * h);
      S[kt] = MFMA32(a, qf[s], S[kt]);
    }
  }
}
DI void pv_tile(const u16* Vs, const f32x16 (&P)[2], f32x16 (&O)[4], int r, int h) {
#pragma unroll
  for (int kt = 0; kt < 2; ++kt)
#pragma unroll
    for (int s = 0; s < 2; ++s) {
      u32x4 pu;
      pu.x = pk2(P[kt][8 * s + 0], P[kt][8 * s + 1]);
      pu.y = pk2(P[kt][8 * s + 2], P[kt][8 * s + 3]);
      pu.z = pk2(P[kt][8 * s + 4], P[kt][8 * s + 5]);
      pu.w = pk2(P[kt][8 * s + 6], P[kt][8 * s + 7]);
      const bf16x8 pf = __builtin_bit_cast(bf16x8, pu);
#pragma unroll
      for (int dt = 0; dt < 4; ++dt) {
        const u16* vp = Vs + (32 * dt + r) * VS_LD + 32 * kt + 16 * s + 4 * h;
        const u32x2 lo = *(const u32x2*)(vp);
        const u32x2 hi = *(const u32x2*)(vp + 8);
        const u32x4 vu = mku4(lo.x, lo.y, hi.x, hi.y);
        O[dt] = MFMA32(__builtin_bit_cast(bf16x8, vu), pf, O[dt]);
      }
    }
}

DI bool tile_on(u32 e0, u32 e1, u32 e2, u32 e3, int j) {
  const u32 wsel = j < 32 ? e0 : (j < 64 ? e1 : (j < 96 ? e2 : e3));
  return (wsel >> (j & 31)) & 1u;
}
DI int tile_next(u32 e0, u32 e1, u32 e2, u32 e3, int j, int j_hi) {
  while (j <= j_hi && !tile_on(e0, e1, e2, e3, j)) ++j;
  return j;
}

constexpr int TILE_BYTES = KS_BYTES + VS_BYTES;
constexpr int SELM_OFF = 2 * TILE_BYTES + 64;

template <class Mask>
DI float softmax_tile(f32x16 (&S)[2], FS& st, float scale2, Mask& mk, int j, int h) {
  mk.begin(j);
  const bool need = Mask::ALWAYS ? true : (__ballot(mk.needs(j)) != 0ull);
  if (need) {
#pragma unroll
    for (int kt = 0; kt < 2; ++kt)
#pragma unroll
      for (int i = 0; i < 16; ++i) {
        const bool ok = mk.ok(kt, i, j * 64 + 32 * kt + crow(i, h));
        S[kt][i] = ok ? S[kt][i] : -INFINITY;
      }
  }
  float mraw = -INFINITY;
#pragma unroll
  for (int kt = 0; kt < 2; ++kt)
#pragma unroll
    for (int i = 0; i < 16; ++i) mraw = fmaxf(mraw, S[kt][i]);
  mraw = fmaxf(mraw, __shfl_xor(mraw, 32));
  const float mold = st.m;
  const float mnew = mraw * scale2;
  float mx = mold;
  if (__ballot(mnew > mold + 8.f) != 0ull) mx = fmaxf(mold, mnew);
  const float alpha = __builtin_amdgcn_exp2f(mold - mx);
  float rs = 0.f;
#pragma unroll
  for (int kt = 0; kt < 2; ++kt)
#pragma unroll
    for (int i = 0; i < 16; ++i) {
      const float pv = __builtin_amdgcn_exp2f(__builtin_fmaf(S[kt][i], scale2, -mx));
      S[kt][i] = pv;
      rs += pv;
    }
  st.l = st.l * alpha + rs;
  st.m = mx;
  return alpha;
}

template <int NS, class Mask>
DI void flash_tiles(FS& st, const bf16x8 (&qf)[NS], const u16* __restrict__ kbase, int ldk, int kcol0,
                    const u16* __restrict__ vtbase, int ldv, int j_lo, int j_hi, u32 e0, u32 e1, u32 e2, u32 e3,
                    float scale2, Mask& mk, char* smem) {
  const int lane = otid() & 63, r = lane & 31, h = lane >> 5;
  int j = tile_next(e0, e1, e2, e3, j_lo, j_hi);
  if (j > j_hi) return;
  TileRegs tr;
  tile_gload_k(tr, kbase + (size_t)j * 64 * ldk, ldk);
  tile_gload_v(tr, vtbase + j * 64, ldv);
  __syncthreads();
  tile_sstore_k(tr, (u16*)smem);
  tile_sstore_v(tr, (u16*)(smem + KS_BYTES));
  int jn = tile_next(e0, e1, e2, e3, j + 1, j_hi);
  if (jn <= j_hi) {
    tile_gload_k(tr, kbase + (size_t)jn * 64 * ldk, ldk);
    tile_gload_v(tr, vtbase + jn * 64, ldv);
  }
  int cur = 0;
  while (true) {
    __syncthreads();
    int jnn = j_hi + 1;
    if (jn <= j_hi) {
      char* nb = smem + (cur ^ 1) * TILE_BYTES;
      tile_sstore_k(tr, (u16*)nb);
      tile_sstore_v(tr, (u16*)(nb + KS_BYTES));
      jnn = tile_next(e0, e1, e2, e3, jn + 1, j_hi);
      if (jnn <= j_hi) {
        tile_gload_k(tr, kbase + (size_t)jnn * 64 * ldk, ldk);
        tile_gload_v(tr, vtbase + jnn * 64, ldv);
      }
    }
    const u16* Ks = (const u16*)(smem + cur * TILE_BYTES);
    const u16* Vs = (const u16*)(smem + cur * TILE_BYTES + KS_BYTES);
    f32x16 S[2];
    __builtin_amdgcn_s_setprio(1);
    qk_tile<NS>(Ks, kcol0, qf, S, r, h);
    __builtin_amdgcn_s_setprio(0);
    const float alpha = softmax_tile(S, st, scale2, mk, j, h);
    if (__ballot(alpha != 1.f) != 0ull) {
#pragma unroll
      for (int dt = 0; dt < 4; ++dt)
#pragma unroll
        for (int i = 0; i < 16; ++i) st.O[dt][i] *= alpha;
    }
    __builtin_amdgcn_s_setprio(1);
    pv_tile(Vs, S, st.O, r, h);
    __builtin_amdgcn_s_setprio(0);
    if (jn > j_hi) break;
    j = jn;
    jn = jnn;
    cur ^= 1;
  }
}

struct MaskCausal {
  static constexpr bool ALWAYS = false;
  int t;
  DI void begin(int) {}
  DI bool needs(int j) const { return 64 * j + 63 > t; }
  DI bool ok(int, int, int key) const { return key <= t; }
};
struct MaskWin {
  static constexpr bool ALWAYS = false;
  int t;
  DI void begin(int) {}
  DI bool needs(int j) const { return 64 * j + 63 > t || 64 * j <= t - 512; }
  DI bool ok(int, int, int key) const { return key <= t && key > t - 512; }
};
struct MaskCmp {
  static constexpr bool ALWAYS = false;
  int cmax;
  DI void begin(int) {}
  DI bool needs(int j) const { return 64 * j + 63 > cmax; }
  DI bool ok(int, int, int key) const { return key <= cmax; }
};
struct MaskNone {
  static constexpr bool ALWAYS = false;
  DI void begin(int) {}
  DI bool needs(int) const { return false; }
  DI bool ok(int, int, int) const { return true; }
};
struct MaskSel {
  static constexpr bool ALWAYS = false;
  int t;
  u32 b0, b1, b2, b3;
  bool on;
  DI void begin(int j) { on = tile_on(b0, b1, b2, b3, j); }
  DI bool needs(int j) const { return !on || 64 * j + 63 > t; }
  DI bool ok(int, int, int key) const { return on && key <= t; }
};
struct MaskDsa {
  static constexpr bool ALWAYS = true;
  const u64* base;
  int sh;
  u32 lo, hi;
  DI void begin(int j) {
    const u64 w = base[(size_t)j * SEQ];
    lo = (u32)w >> sh;
    hi = (u32)(w >> 32) >> sh;
  }
  DI bool needs(int) const { return true; }
  DI bool ok(int kt, int i, int) const { return (((kt ? hi : lo) >> ((i & 3) + 8 * (i >> 2))) & 1u) != 0u; }
};

template <int NS>
DI void load_q(bf16x8 (&qf)[NS], const u16* __restrict__ qrow, int h) {
#pragma unroll
  for (int s = 0; s < NS; ++s) qf[s] = *(const bf16x8*)(qrow + 16 * s + 8 * h);
}
DI void fs_init(FS& st) {
#pragma unroll
  for (int i = 0; i < 4; ++i) zero16(st.O[i]);
  st.m = -3.0e38f;
  st.l = 0.f;
}
DI float fs_invl(const FS& st) {
  const float lt = st.l + __shfl_xor(st.l, 32);
  return lt > 0.f ? 1.f / lt : 0.f;
}

template <bool ACCUM>
DI void store_gated(const f32x16 (&O)[4], float coef, const u16* __restrict__ zrow, u16* __restrict__ yrow, int h) {
#pragma unroll
  for (int hb = 0; hb < 2; ++hb) {
    u32x2 zz[8], yy[8];
#pragma unroll
    for (int k = 0; k < 8; ++k) {
      const int dt = 2 * hb + (k >> 2), ig = k & 3;
      const int d = 32 * dt + 8 * ig + 4 * h;
      zz[k] = *(const u32x2*)(zrow + d);
      if (ACCUM) yy[k] = *(const u32x2*)(yrow + d);
    }
#pragma unroll
    for (int k = 0; k < 8; ++k) {
      const int dt = 2 * hb + (k >> 2), ig = k & 3;
      const int d = 32 * dt + 8 * ig + 4 * h;
      const u32x2 z2 = zz[k];
      float v0 = coef * O[dt][4 * ig] * siluf(bflo(z2.x));
      float v1 = coef * O[dt][4 * ig + 1] * siluf(bfhi(z2.x));
      float v2 = coef * O[dt][4 * ig + 2] * siluf(bflo(z2.y));
      float v3 = coef * O[dt][4 * ig + 3] * siluf(bfhi(z2.y));
      if (ACCUM) {
        const u32x2 y2 = yy[k];
        v0 += bflo(y2.x);
        v1 += bfhi(y2.x);
        v2 += bflo(y2.y);
        v3 += bfhi(y2.y);
      }
      u32x2 o;
      o.x = pk2(v0, v1);
      o.y = pk2(v2, v3);
      *(u32x2*)(yrow + d) = o;
    }
    __builtin_amdgcn_sched_barrier(0);
  }
}

constexpr u32 ALLON = 0xffffffffu;

DI void item_diff(const Params& p, int layer, int id, char* smem) {
  char* ws = ows(p.ws);
  const int e = layer >> 1;
  const int qt = 127 - (id >> 3), b = (id >> 2) & 1, hd = id & 3;
  const int tid = otid(), lane = tid & 63, w = tid >> 6, r = lane & 31, h = lane >> 5;
  const int c = w >> 1;
  const int t = qt * 64 + 32 * (w & 1) + r;
  const size_t tok = (size_t)b * SEQ + t;
  bf16x8 qf[4];
  load_q<4>(qf, (const u16*)(ws + E_BQ) + tok * 512 + hd * 128 + c * 64, h);
  FS st;
  fs_init(st);
  MaskCausal mk{t};
  flash_tiles<4>(st, qf, (const u16*)(ws + E_BK) + (size_t)b * SEQ * 512 + hd * 128, 512, 64 * c,
                       (const u16*)(ws + E_BVT) + (size_t)((b * 4 + hd) * 128) * SEQ, SEQ, 0, qt, ALLON, ALLON, ALLON,
                       ALLON, 0.125f * LOG2E, mk, smem);
  const float il = fs_invl(st);
  float* ex = (float*)smem;
  __syncthreads();
  if (c == 1) {
#pragma unroll
    for (int dt = 0; dt < 4; ++dt)
#pragma unroll
      for (int i = 0; i < 16; ++i) ex[((w & 1) * 64 + dt * 16 + i) * 64 + lane] = st.O[dt][i] * il;
  }
  __syncthreads();
  if (c == 0) {
    const float lambda_init = 0.8f - 0.6f * expf(-0.3f * (float)layer);
    const float lam = ((const float*)(ws + OFF_MISC))[e] + lambda_init;
    float ss = 0.f;
#pragma unroll
    for (int dt = 0; dt < 4; ++dt)
#pragma unroll
      for (int i = 0; i < 16; ++i) {
        const float a = st.O[dt][i] * il - lam * ex[((w & 1) * 64 + dt * 16 + i) * 64 + lane];
        st.O[dt][i] = a;
        ss += a * a;
      }
    ss += __shfl_xor(ss, 32);
    const float rinv = rsqrtf(ss * (1.f / 128.f) + EPS) * (1.f - lambda_init);
    const float* sg = p.diff_subln_gain + e * 128;
#pragma unroll
    for (int dt = 0; dt < 4; ++dt)
#pragma unroll
      for (int ig = 0; ig < 4; ++ig) {
        const f32x4 g = *(const f32x4*)(sg + 32 * dt + 8 * ig + 4 * h);
        st.O[dt][4 * ig] *= g.x;
        st.O[dt][4 * ig + 1] *= g.y;
        st.O[dt][4 * ig + 2] *= g.z;
        st.O[dt][4 * ig + 3] *= g.w;
      }
    store_gated<false>(st.O, rinv, (const u16*)(ws + OFF_Z) + tok * DM + 1024 + hd * 128,
                       (u16*)(ws + OFF_HY) + tok * DM + 1024 + hd * 128, h);
  }
}

DI void item_win(const Params& p, int id, char* smem) {
  char* ws = ows(p.ws);
  const int qt = id >> 2, b = (id >> 1) & 1, g = id & 1;
  const int tid = otid(), lane = tid & 63, w = tid >> 6, r = lane & 31, h = lane >> 5;
  const int t = qt * 32 + 8 * w + (r & 7), hq = 4 * g + (r >> 3);
  const size_t tok = (size_t)b * SEQ + t;
  bf16x8 qf[8];
  load_q<8>(qf, (const u16*)(ws + E_QA) + tok * 1024 + hq * 128, h);
  FS st;
  fs_init(st);
  MaskWin mk{t};
  int lo = qt * 32 - 511;
  lo = lo < 0 ? 0 : lo >> 6;
  flash_tiles<8>(st, qf, (const u16*)(ws + E_KW) + (size_t)b * SEQ * 256 + g * 128, 256, 0,
                       (const u16*)(ws + E_VWT) + (size_t)((b * 2 + g) * 128) * SEQ, SEQ, lo, (qt * 32 + 31) >> 6, ALLON,
                       ALLON, ALLON, ALLON, 0.08838834764831845f * LOG2E, mk, smem);
  const float il = fs_invl(st);
  const float gate = sigmf(((const float*)(ws + E_AG))[tok * 32 + hq * 3 + 2]);
  store_gated<false>(st.O, il * gate, (const u16*)(ws + OFF_Z) + tok * DM + hq * 128, (u16*)(ws + OFF_HY) + tok * DM + hq * 128,
                     h);
}

DI void item_sel(const Params& p, int id, char* smem) {
  char* ws = ows(p.ws);
  const int qt = 255 - (id >> 2), b = (id >> 1) & 1, g = id & 1;
  const int tid = otid(), lane = tid & 63, w = tid >> 6, r = lane & 31, h = lane >> 5;
  const int t = qt * 32 + 8 * w + (r & 7), hq = 4 * g + (r >> 3);
  const size_t tok = (size_t)b * SEQ + t;
  __syncthreads();
  const u32x4 sm4 = *(const u32x4*)((const u32*)(smem + SELM_OFF) + (8 * w + (r & 7)) * 4);
  u32 u0 = sm4.x, u1 = sm4.y, u2 = sm4.z, u3 = sm4.w;
#pragma unroll
  for (int o = 1; o <= 4; o <<= 1) {
    u0 |= __shfl_xor(u0, o);
    u1 |= __shfl_xor(u1, o);
    u2 |= __shfl_xor(u2, o);
    u3 |= __shfl_xor(u3, o);
  }
  u32* us = (u32*)(smem + 2 * TILE_BYTES);
  __syncthreads();
  if (lane == 0) {
    us[w * 4 + 0] = u0;
    us[w * 4 + 1] = u1;
    us[w * 4 + 2] = u2;
    us[w * 4 + 3] = u3;
  }
  __syncthreads();
  u0 = us[0] | us[4] | us[8] | us[12];
  u1 = us[1] | us[5] | us[9] | us[13];
  u2 = us[2] | us[6] | us[10] | us[14];
  u3 = us[3] | us[7] | us[11] | us[15];
  bf16x8 qf[8];
  load_q<8>(qf, (const u16*)(ws + E_QA) + tok * 1024 + hq * 128, h);
  FS st;
  fs_init(st);
  MaskSel mk{t, sm4.x, sm4.y, sm4.z, sm4.w, false};
  flash_tiles<8>(st, qf, (const u16*)(ws + E_KS) + (size_t)b * SEQ * 256 + g * 128, 256, 0,
                       (const u16*)(ws + E_VST) + (size_t)((b * 2 + g) * 128) * SEQ, SEQ, 0, (qt * 32 + 31) >> 6, u0, u1, u2,
                       u3, 0.08838834764831845f * LOG2E, mk, smem);
  const float il = fs_invl(st);
  const float gate = sigmf(((const float*)(ws + E_AG))[tok * 32 + hq * 3 + 1]);
  store_gated<true>(st.O, il * gate, (const u16*)(ws + OFF_Z) + tok * DM + hq * 128, (u16*)(ws + OFF_HY) + tok * DM + hq * 128,
                    h);
}

DI void item_cmp(const Params& p, int id, char* smem) {
  char* ws = ows(p.ws);
  const int qt = 255 - (id >> 2), b = (id >> 1) & 1, g = id & 1;
  const int tid = otid(), lane = tid & 63, w = tid >> 6, r = lane & 31, h = lane >> 5;
  const int tl = 8 * w + (r & 7);
  const int t = qt * 32 + tl, hq = 4 * g + (r >> 3);
  const size_t tok = (size_t)b * SEQ + t;
  const float scale2 = 0.08838834764831845f * LOG2E;
  u16* Ks = (u16*)smem;
  u16* Vs = (u16*)(smem + KS_BYTES);
  float* imp = (float*)(smem + KS_BYTES + VS_BYTES);
  __syncthreads();
  for (int i = tid; i < 32 * 132; i += NTHREADS) imp[i] = 0.f;
  bf16x8 qf[8];
  load_q<8>(qf, (const u16*)(ws + E_QA) + tok * 1024 + hq * 128, h);
  FS st;
  fs_init(st);
  MaskCmp mk{t >= 31 ? ((t - 31) >> 4) : -1};
  const int j_hi = qt >> 5;
  const u16* kbase = (const u16*)(ws + E_KC) + (size_t)b * 512 * 256 + g * 128;
  const u16* vtbase = (const u16*)(ws + E_VCT) + (size_t)((b * 2 + g) * 128) * 512;
  for (int j = 0; j <= j_hi; ++j) {
    TileRegs tr;
    tile_gload_k(tr, kbase + (size_t)j * 64 * 256, 256);
    __syncthreads();
    tile_sstore_k(tr, Ks);
    __syncthreads();
    f32x16 S[2];
    qk_tile<8>(Ks, 0, qf, S, r, h);
    softmax_tile(S, st, scale2, mk, j, h);
  }
  const float il = fs_invl(st);
  const float mfin = st.m;
  for (int j = 0; j <= j_hi; ++j) {
    TileRegs tr;
    tile_gload_k(tr, kbase + (size_t)j * 64 * 256, 256);
    tile_gload_v(tr, vtbase + j * 64, 512);
    __syncthreads();
    tile_sstore_k(tr, Ks);
    tile_sstore_v(tr, Vs);
    __syncthreads();
    f32x16 S[2];
    qk_tile<8>(Ks, 0, qf, S, r, h);
#pragma unroll
    for (int kt = 0; kt < 2; ++kt) {
#pragma unroll
      for (int i = 0; i < 16; ++i) {
        const int key = j * 64 + 32 * kt + crow(i, h);
        S[kt][i] = key <= mk.cmax ? __builtin_amdgcn_exp2f(S[kt][i] * scale2 - mfin) * il : 0.f;
      }
#pragma unroll
      for (int ig = 0; ig < 4; ++ig) {
        float vm = S[kt][4 * ig] + S[kt][4 * ig + 1] + S[kt][4 * ig + 2] + 0.5f * S[kt][4 * ig + 3];
        float vn = 0.5f * S[kt][4 * ig + 3];
        vm += __shfl_xor(vm, 8);
        vn += __shfl_xor(vn, 8);
        vm += __shfl_xor(vm, 16);
        vn += __shfl_xor(vn, 16);
        if ((r >> 3) == 0) {
          const int jj = 16 * j + 8 * kt + 2 * ig + h;
          atomicAdd(&imp[tl * 132 + jj], vm);
          atomicAdd(&imp[tl * 132 + jj + 1], vn);
        }
      }
    }
    pv_tile(Vs, S, st.O, r, h);
  }
  const float gate = sigmf(((const float*)(ws + E_AG))[tok * 32 + hq * 3 + 0]);
  store_gated<true>(st.O, gate, (const u16*)(ws + OFF_Z) + tok * DM + hq * 128, (u16*)(ws + OFF_HY) + tok * DM + hq * 128, h);
  __syncthreads();
  for (int q = 0; q < 8; ++q) {
    const int tl2 = 8 * w + q;
    const int t2 = qt * 32 + tl2;
    const int cur = t2 >> 6;
    const int j0 = lane, j1 = lane + 64;
    float v0 = j0 > cur ? -1e30f : ((j0 == 0 || j0 >= cur - 1) ? 1e9f : imp[tl2 * 132 + j0]);
    float v1 = j1 > cur ? -1e30f : ((j1 >= cur - 1) ? 1e9f : imp[tl2 * 132 + j1]);
    u32 m0 = 0, m1 = 0, m2 = 0, m3 = 0;
    for (int rd = 0; rd < 16; ++rd) {
      float bv = v0;
      int bj = j0;
      if (v1 > v0) {
        bv = v1;
        bj = j1;
      }
#pragma unroll
      for (int o = 32; o >= 1; o >>= 1) {
        const float ov = __shfl_xor(bv, o);
        const int oj = __shfl_xor(bj, o);
        if (ov > bv || (ov == bv && oj < bj)) {
          bv = ov;
          bj = oj;
        }
      }
      const u32 bit = 1u << (bj & 31);
      if (bj < 32) m0 |= bit;
      else if (bj < 64) m1 |= bit;
      else if (bj < 96) m2 |= bit;
      else m3 |= bit;
      if (bj == j0) v0 = -3e38f;
      if (bj == j1) v1 = -3e38f;
    }
    const int nb = cur + 1;
    const u32 k0 = nb >= 32 ? ALLON : ((1u << nb) - 1u);
    const u32 k1 = nb >= 64 ? ALLON : (nb <= 32 ? 0u : ((1u << (nb - 32)) - 1u));
    const u32 k2 = nb >= 96 ? ALLON : (nb <= 64 ? 0u : ((1u << (nb - 64)) - 1u));
    const u32 k3 = nb >= 128 ? ALLON : (nb <= 96 ? 0u : ((1u << (nb - 96)) - 1u));
    if (lane == 0)
      *(u32x4*)((u32*)(smem + SELM_OFF) + tl2 * 4) = mku4(m0 & k0, m1 & k1, m2 & k2, m3 & k3);
  }
}

DI void item_mem(const Params& p, int layer, int id, char* smem) {
  char* ws = ows(p.ws);
  const int par = layer & 1;
  const int qt = id >> 3, b = (id >> 2) & 1, hm = id & 3;
  const int tid = otid(), lane = tid & 63, w = tid >> 6, r = lane & 31, h = lane >> 5;
  const int t = qt * 128 + 32 * w + r;
  const size_t tok = (size_t)b * SEQ + t;
  bf16x8 qf[8];
  load_q<8>(qf, (const u16*)(ws + (par ? O_MQ : E_MQ)) + tok * 512 + hm * 128, h);
  FS st;
  fs_init(st);
  MaskNone mk;
  flash_tiles<8>(st, qf, (const u16*)(ws + OFF_MEMK) + ((size_t)layer * 512 + b * 256) * 512 + hm * 128, 512, 0,
                       (const u16*)(ws + OFF_MEMVT) + (size_t)(((layer * 2 + b) * 4 + hm) * 128) * 256, 256, 0, 3, ALLON,
                       ALLON, ALLON, ALLON, 0.08838834764831845f * LOG2E, mk, smem);
  const float il = fs_invl(st);
  store_gated<false>(st.O, il, (const u16*)(ws + OFF_Z) + tok * DM + 1536 + hm * 128,
                     (u16*)(ws + OFF_HY) + tok * DM + 1536 + hm * 128, h);
}

DI void item_dsa(const Params& p, int id, char* smem) {
  char* ws = ows(p.ws);
  const int qt = 63 - id / 24, rem = id % 24, b = rem / 12, hd = rem % 12, g = hd / 3;
  const int tid = otid(), lane = tid & 63, w = tid >> 6, r = lane & 31, h = lane >> 5;
  const int t = qt * 128 + 32 * w + r;
  const size_t tok = (size_t)b * SEQ + t;
  bf16x8 qf[8];
  load_q<8>(qf, (const u16*)(ws + O_CQ) + tok * 1536 + hd * 128, h);
  FS st;
  fs_init(st);
  MaskDsa mk{(const u64*)(ws + O_DMASK) + (size_t)b * 128 * SEQ + t, 4 * h, 0u, 0u};
  flash_tiles<8>(st, qf, (const u16*)(ws + O_CK) + (size_t)b * SEQ * 512 + g * 128, 512, 0,
                       (const u16*)(ws + O_CVT) + (size_t)((b * 4 + g) * 128) * SEQ, SEQ, 0, 2 * qt + 1, ALLON, ALLON, ALLON,
                       ALLON, 0.08838834764831845f * LOG2E, mk, smem);
  const float il = fs_invl(st);
  store_gated<false>(st.O, il, (const u16*)(ws + OFF_Z) + tok * DM + hd * 128, (u16*)(ws + OFF_HY) + tok * DM + hd * 128, h);
}

DI size_t sc_row(int b, int t) {
  const int q = t >> 7;
  return (size_t)b * SC_PER_B + (size_t)16384 * (q * (q + 1) / 2) + (size_t)(t & 127) * (128 * (q + 1));
}
constexpr int QS_LD = 1032;
DI void item_idx(const Params& p, int b, int qt32, int ch, char* smem) {
  char* ws = ows(p.ws);
  u16* Qs = (u16*)smem;
  float* wsm = (float*)(smem + 32 * QS_LD * 2);
  const int tid = otid(), lane = tid & 63, w = tid >> 6, r = lane & 31, h = lane >> 5;
  const int q0 = qt32 * 32;
  const int Lq = 128 * ((q0 >> 7) + 1);
  __syncthreads();
  {
    const u16* iq = (const u16*)(ws + O_IQ) + ((size_t)b * SEQ + q0) * 1024;
#pragma unroll
    for (int i = 0; i < 16; ++i) {
      const int c = tid + 256 * i;
      *(u32x4*)(Qs + (c >> 7) * QS_LD + (c & 127) * 8) = *(const u32x4*)(iq + (size_t)(c >> 7) * 1024 + (c & 127) * 8);
    }
    const float* iw = (const float*)(ws + O_IW) + ((size_t)b * SEQ + q0) * 16;
    for (int i = tid; i < 512; i += NTHREADS) wsm[i] = iw[i];
  }
  __syncthreads();
  const int key0 = ch * 512 + 128 * w;
  if (key0 >= Lq) return;
  const u16* ik = (const u16*)(ws + O_IK) + ((size_t)b * SEQ + key0) * 64;
  bf16x8 kf[4][4];
#pragma unroll
  for (int sub = 0; sub < 4; ++sub)
#pragma unroll
    for (int s = 0; s < 4; ++s) kf[sub][s] = *(const bf16x8*)(ik + (size_t)(32 * sub + r) * 64 + 16 * s + 8 * h);
  f32x16 acc[4];
#pragma unroll
  for (int i = 0; i < 4; ++i) zero16(acc[i]);
#pragma unroll 1
  for (int hh = 0; hh < 16; ++hh) {
    const float wv = wsm[r * 16 + hh];
    bf16x8 qf[4];
#pragma unroll
    for (int s = 0; s < 4; ++s) qf[s] = *(const bf16x8*)(Qs + r * QS_LD + hh * 64 + 16 * s + 8 * h);
#pragma unroll
    for (int sub = 0; sub < 4; ++sub) {
      f32x16 sx;
      zero16(sx);
      __builtin_amdgcn_s_setprio(1);
#pragma unroll
      for (int s = 0; s < 4; ++s) sx = MFMA32(kf[sub][s], qf[s], sx);
      __builtin_amdgcn_s_setprio(0);
#pragma unroll
      for (int i = 0; i < 16; ++i) {
        const float xf = sx[i];
        const int xb = __float_as_int(xf);
        acc[sub][i] += wv * __int_as_float(xb > 0 ? xb : 0);
      }
    }
  }
  const int t = q0 + r;
  u16* srow = (u16*)(ws + O_SC) + sc_row(b, t) + key0;
#pragma unroll
  for (int sub = 0; sub < 4; ++sub)
#pragma unroll
    for (int ig = 0; ig < 4; ++ig) {
      u16 hv[4];
#pragma unroll
      for (int q = 0; q < 4; ++q) {
        const _Float16 f = (_Float16)acc[sub][4 * ig + q];
        hv[q] = __builtin_bit_cast(u16, f);
      }
      u32x2 o;
      o.x = (u32)hv[0] | ((u32)hv[1] << 16);
      o.y = (u32)hv[2] | ((u32)hv[3] << 16);
      *(u32x2*)(srow + 32 * sub + 8 * ig + 4 * h) = o;
    }
}
DI void phase_idx(const Params& p, char* smem) {
  const int G = gridDim.x;
  for (int it = blockIdx.x; it < 2 * 2176; it += G) {
    const int b = it & 1;
    const int idx = it >> 1;
    int q4 = 0;
    while (q4 < 15 && 8 * (q4 + 1) * (q4 + 2) <= idx) ++q4;
    const int rem = idx - 8 * q4 * (q4 + 1);
    const int ch = rem >> 4, qt32 = q4 * 16 + (rem & 15);
    item_idx(p, b, qt32, ch, smem);
  }
}

DI u32 okey(u32 hbits) { return (hbits & 0x8000u) ? (~hbits & 0xffffu) : (hbits | 0x8000u); }
DI void wave_lds_sync() {
  __builtin_amdgcn_fence(__ATOMIC_SEQ_CST, "workgroup");
  __builtin_amdgcn_wave_barrier();
}
DI int find_bin(const u32* hist, int lane, u32 target, u32& above) {
  const u32 c0 = hist[4 * lane], c1 = hist[4 * lane + 1], c2 = hist[4 * lane + 2], c3 = hist[4 * lane + 3];
  const u32 tot = c0 + c1 + c2 + c3;
  u32 suf = tot;
#pragma unroll
  for (int o = 1; o < 64; o <<= 1) {
    const u32 v = __shfl_down(suf, o);
    if (lane + o < 64) suf += v;
  }
  const u64 bal = __ballot(suf >= target);
  const int sl = 63 - __builtin_clzll(bal | 1ull);
  u32 a = suf - tot;
  int bin;
  if (a + c3 >= target) bin = 3;
  else {
    a += c3;
    if (a + c2 >= target) bin = 2;
    else {
      a += c2;
      if (a + c1 >= target) bin = 1;
      else {
        a += c1;
        bin = 0;
      }
    }
  }
  const int resb = __shfl(4 * lane + bin, sl);
  above = __shfl(a, sl);
  return resb;
}
DI void phase_select(const Params& p, char* smem) {
  char* ws = ows(p.ws);
  const int tid = otid(), lane = tid & 63, w = tid >> 6;
  u32* hist = (u32*)smem + w * 256;
  const int gw = blockIdx.x * 4 + w, nw = gridDim.x * 4;
  u64* dmask = (u64*)(ws + O_DMASK);
  for (int row = gw; row < NTOK; row += nw) {
    const int b = row & 1, t = SEQ - 1 - (row >> 1);
    const int L = t + 1;
    const u16* srow = (const u16*)(ws + O_SC) + sc_row(b, t);
    u32 T = 0, need = 0x7fffffffu;
    const bool all = L <= 256;
    if (!all) {
      const int nit = (L + 511) >> 9;
      wave_lds_sync();
#pragma unroll
      for (int i = 0; i < 4; ++i) hist[lane + 64 * i] = 0;
      wave_lds_sync();
      for (int it = 0; it < nit; ++it) {
        const int i0 = it * 512 + lane * 8;
        const u32x4 v = *(const u32x4*)(srow + i0);
        const u32 vv[4] = {v.x, v.y, v.z, v.w};
#pragma unroll
        for (int q = 0; q < 8; ++q) {
          const u32 k = okey((vv[q >> 1] >> (16 * (q & 1))) & 0xffffu);
          if (i0 + q <= t) atomicAdd(&hist[k >> 8], 1u);
        }
      }
      wave_lds_sync();
      u32 above1;
      const int b1 = find_bin(hist, lane, 256u, above1);
      wave_lds_sync();
#pragma unroll
      for (int i = 0; i < 4; ++i) hist[lane + 64 * i] = 0;
      wave_lds_sync();
      for (int it = 0; it < nit; ++it) {
        const int i0 = it * 512 + lane * 8;
        const u32x4 v = *(const u32x4*)(srow + i0);
        const u32 vv[4] = {v.x, v.y, v.z, v.w};
#pragma unroll
        for (int q = 0; q < 8; ++q) {
          const u32 k = okey((vv[q >> 1] >> (16 * (q & 1))) & 0xffffu);
          if (i0 + q <= t && (int)(k >> 8) == b1) atomicAdd(&hist[k & 255u], 1u);
        }
      }
      wave_lds_sync();
      u32 above2;
      const int b2 = find_bin(hist, lane, 256u - above1, above2);
      T = ((u32)b1 << 8) | (u32)b2;
      need = 256u - above1 - above2;
    }
    const int ktmax = 2 * (t >> 7) + 1;
    const int nit3 = (ktmax + 1 + 7) >> 3;
    u32 tie_base = 0;
    for (int it = 0; it < nit3; ++it) {
      const int i0 = it * 512 + lane * 8;
      const u32x4 v = *(const u32x4*)(srow + i0);
      const u32 vv[4] = {v.x, v.y, v.z, v.w};
      u32 kk[8];
      u32 tc = 0;
#pragma unroll
      for (int q = 0; q < 8; ++q) {
        kk[q] = okey((vv[q >> 1] >> (16 * (q & 1))) & 0xffffu);
        if (i0 + q <= t && kk[q] == T) ++tc;
      }
      u32 inc = tc;
#pragma unroll
      for (int o = 1; o < 64; o <<= 1) {
        const u32 x = __shfl_up(inc, o);
        if (lane >= o) inc += x;
      }
      u32 rank = tie_base + inc - tc;
      tie_base += __shfl(inc, 63);
      u32 byte = 0;
#pragma unroll
      for (int q = 0; q < 8; ++q) {
        const bool valid = i0 + q <= t;
        bool s = false;
        if (valid) {
          if (all || kk[q] > T) s = true;
          else if (kk[q] == T) {
            s = rank < need;
            ++rank;
          }
        }
        byte |= (s ? 1u : 0u) << q;
      }
      const int sh = 8 * (lane & 7);
      u32 wlo = sh < 32 ? (byte << sh) : 0u;
      u32 whi = sh >= 32 ? (byte << (sh - 32)) : 0u;
#pragma unroll
      for (int o = 1; o <= 4; o <<= 1) {
        wlo |= __shfl_xor(wlo, o);
        whi |= __shfl_xor(whi, o);
      }
      const int kt = it * 8 + (lane >> 3);
      if ((lane & 7) == 0 && kt <= ktmax) dmask[((size_t)b * 128 + kt) * SEQ + t] = ((u64)whi << 32) | (u64)wlo;
    }
  }
}


#define XB_TMO      128
#define XB_XCNT(j)  (256  + 64 * (j))
#define XB_XSUB(j)  (1280 + 64 * (j))
#define XB_XGEN(j)  (2304 + 64 * (j))
#define XB_TOP      3328
#define XB_TOPGEN   3392
#define XCD_BAR_WORDS 3456
#define XB_SPIN_CAP (1u << 22)
#define LAS __attribute__((address_space(3)))
DI unsigned xb_ld(unsigned* p) { return __hip_atomic_load(p, __ATOMIC_RELAXED, __HIP_MEMORY_SCOPE_AGENT); }
DI unsigned xb_add(unsigned* p, unsigned v) { return __hip_atomic_fetch_add(p, v, __ATOMIC_RELAXED, __HIP_MEMORY_SCOPE_AGENT); }
DI unsigned xb_xcc_id() { return (unsigned)__builtin_amdgcn_s_getreg((3 << 11) | 20) & 0xFu; }
#define XB_SPIN(cond, bar) do { unsigned _sp = 0; while (cond) { __builtin_amdgcn_s_sleep(1); \
    if ((++_sp & 255u) == 0u) { if (xb_ld(&(bar)[XB_TMO])) break; if (_sp > XB_SPIN_CAP) { atomicAdd(&(bar)[XB_TMO], 1u); break; } } } } while (0)
struct XcdBarrier {
  unsigned* bar;
  unsigned x;
  volatile LAS unsigned* st;
};
DI void xcd_barrier_complete(unsigned* bar, unsigned x, unsigned& nloc, unsigned& nx) {
  const unsigned G = gridDim.x * gridDim.y * gridDim.z;
  unsigned sum, cnt, mine, sp = 0u;
  for (;;) {
    sum = 0u; cnt = 0u; mine = 0u;
#pragma unroll 1
    for (unsigned j = 0; j < 16; ++j) { const unsigned c = xb_ld(&bar[XB_XCNT(j)]); sum += c; cnt += (c > 0u) ? 1u : 0u; mine = (j == x) ? c : mine; }
    if (sum == G) break;
    __builtin_amdgcn_s_sleep(1);
    if ((++sp & 255u) == 0u) { if (xb_ld(&bar[XB_TMO])) break; if (sp > XB_SPIN_CAP) { atomicAdd(&bar[XB_TMO], 1u); break; } }
  }
  nloc = mine > 0u ? mine : 1u; nx = cnt > 0u ? cnt : 1u;
}
DI void xcd_barrier(const XcdBarrier& b) {
  asm volatile("s_waitcnt vmcnt(0)" ::: "memory");
  __syncthreads();
  if (__builtin_amdgcn_workitem_id_x() == 0) {
    unsigned* bar = (unsigned*)ows((char*)b.bar);
    __builtin_amdgcn_s_waitcnt(0);
    unsigned nloc = b.st[0], nx = b.st[1];
    if (nloc == 0u) { xcd_barrier_complete(bar, b.x, nloc, nx); b.st[0] = nloc; b.st[1] = nx; }
    const unsigned old = xb_add(&bar[XB_XSUB(b.x)], 1u);
    const unsigned gen = old / nloc;
    if (old + 1u == (gen + 1u) * nloc) {
      __builtin_amdgcn_fence(__ATOMIC_RELEASE, "agent");
      asm volatile("s_waitcnt vmcnt(0)" ::: "memory");
      const unsigned og = xb_add(&bar[XB_TOP], 1u);
      const unsigned tg = og / nx;
      if (og + 1u == (tg + 1u) * nx) xb_add(&bar[XB_TOPGEN], 1u);
      else XB_SPIN(xb_ld(&bar[XB_TOPGEN]) == tg, bar);
      __builtin_amdgcn_fence(__ATOMIC_ACQUIRE, "agent");
      xb_add(&bar[XB_XGEN(b.x)], 1u);
      asm volatile("s_waitcnt vmcnt(0)" ::: "memory");
    } else {
      XB_SPIN(xb_ld(&bar[XB_XGEN(b.x)]) == gen, bar);
      __builtin_amdgcn_fence(__ATOMIC_ACQUIRE, "agent");
      asm volatile("s_waitcnt vmcnt(0)" ::: "memory");
    }
  }
  __syncthreads();
}

DI XcdInfo xcd_info(const XcdBarrier& b, int* s_tmp) {
  __syncthreads();
  if (__builtin_amdgcn_workitem_id_x() == 0) {
    int xi = 0;
    unsigned* bar = (unsigned*)ows((char*)b.bar);
#pragma unroll 1
    for (unsigned j = 0; j < 16; ++j) {
      const unsigned c = xb_ld(&bar[XB_XCNT(j)]);
      if (j < b.x && c > 0u) ++xi;
    }
    s_tmp[0] = xi;
  }
  __syncthreads();
  XcdInfo r;
  r.xi = s_tmp[0];
  r.nloc = (int)b.st[0];
  r.nx = (int)b.st[1];
  r.lrank = (int)b.st[2];
  return r;
}

DI void run_phase(const Params& p, int ph, char* smem, int* s_item, const XcdBarrier& xb) {
  int layer, lp;
  if (ph < 6) { layer = 0; lp = ph; }
  else if (ph < 12) { layer = 1; lp = ph - 6; }
  else if (ph < 18) { layer = 2; lp = ph - 12; }
  else { layer = 3; lp = ph - 18; }
  int* ctr = (int*)(ows(p.ws) + OFF_CTR) + layer * 8;
  if (!(layer & 1)) {
    switch (lp) {
      case 0: phase_prep(p, layer, smem); break;
      case 1: phase_proj(p, layer, smem, xcd_info(xb, s_item)); break;
      case 2: {
        mlp1_tiles(p, smem);
        int it;
        while ((it = next_item(ctr + 0, s_item)) < 2560) {
          if (it < 1024) item_diff(p, layer, it, smem);
          else if (it < 2048) item_win(p, it - 1024, smem);
          else item_mem(p, layer, it - 2048, smem);
        }
      } break;
      case 3: phase_mlp2(p, layer, smem); break;
      case 4: {
        int it;
        while ((it = next_item(ctr + 1, s_item)) < 1024) {
          item_cmp(p, it, smem);
          item_sel(p, it, smem);
        }
      } break;
      default: phase_outproj(p, layer, smem, xcd_info(xb, s_item)); break;
    }
  } else {
    switch (lp) {
      case 0: phase_prep(p, layer, smem); break;
      case 1: phase_proj(p, layer, smem, xcd_info(xb, s_item)); break;
      case 2: {
        phase_idx(p, smem);
        int it;
        while ((it = next_item(ctr + 0, s_item)) < 512) item_mem(p, layer, it, smem);
      } break;
      case 3: phase_select(p, smem); break;
      case 4: {
        int it;
        while ((it = next_item(ctr + 1, s_item)) < 1536) item_dsa(p, it, smem);
      } break;
      default: phase_outproj(p, layer, smem, xcd_info(xb, s_item)); break;
    }
  }
}

constexpr int SMEM_BYTES = 2 * TILE_BYTES + 64 + 512;
constexpr int N_PHASES = 24;

__global__ void __launch_bounds__(NTHREADS, 2) trunk_megakernel(Params p) {
  __shared__ __attribute__((aligned(16))) char smem[SMEM_BYTES];
  __shared__ int s_item;
  __shared__ u32x4 xb_words;
  cg::grid_group grid = cg::this_grid();
  XcdBarrier xb;
  xb.bar = (unsigned*)(p.ws + OFF_BAR);
  xb.x = xb_xcc_id();
  xb.st = (volatile LAS unsigned*)&xb_words;
  if (__builtin_amdgcn_workitem_id_x() == 0) {
    xb.st[0] = 0u;
    xb.st[1] = 0u;
  }
  __syncthreads();
  if (__builtin_amdgcn_workitem_id_x() == 0) xb.st[2] = xb_add(&xb.bar[XB_XCNT(xb.x)], 1u);
  if (p.ph_end < 0) grid.sync();
  if (p.ph_begin == 0) phase_prep0_extra(p, smem);
  for (int ph = p.ph_begin; ph < p.ph_end; ++ph) {
    run_phase(p, ph, smem, &s_item, xb);
    if (ph + 1 < p.ph_end) xcd_barrier(xb);
  }
}

extern "C" void kernel_launch(void* const* d_in, const int* in_sizes, int n_in, void* d_out, int out_size, void* d_ws,
                              size_t ws_size, hipStream_t stream) {
  static int grid_blocks = 0;
  if (!grid_blocks) {
    int dev = 0, cus = 0, per_cu = 0;
    (void)hipGetDevice(&dev);
    (void)hipDeviceGetAttribute(&cus, hipDeviceAttributeMultiprocessorCount, dev);
    (void)hipOccupancyMaxActiveBlocksPerMultiprocessor(&per_cu, trunk_megakernel, NTHREADS, 0);
    if (per_cu > 2) per_cu = 2;
    if (per_cu < 1) per_cu = 1;
    grid_blocks = cus * per_cu;
  }
  Params p;
  memset(&p, 0, sizeof(p));
  p.x = (const float*)d_in[0];
  p.mem = (const float*)d_in[1];
  p.norm_gain = (const float*)d_in[2];
  p.mem_norm_gain = (const float*)d_in[3];
  p.mem_w_kv = (const float*)d_in[4];
  p.mem_qk_gain = (const float*)d_in[5];
  p.w_out = (const float*)d_in[6];
  p.even_w_in = (const float*)d_in[7];
  p.nsa_qk_gain = (const float*)d_in[8];
  p.nsa_cmp_pos = (const float*)d_in[9];
  p.nsa_cmp_w1 = (const float*)d_in[10];
  p.nsa_cmp_w2 = (const float*)d_in[11];
  p.diff_qk_gain = (const float*)d_in[12];
  p.diff_lambda = (const float*)d_in[13];
  p.diff_subln_gain = (const float*)d_in[14];
  p.odd_w_in = (const float*)d_in[15];
  p.dsa_qk_gain = (const float*)d_in[16];
  p.out = (float*)d_out;
  p.ws = (char*)d_ws;
  p.ph_begin = 0;
  p.ph_end = N_PHASES;
  (void)hipMemsetAsync(d_ws, 0, 4096, stream);
  (void)hipMemsetAsync((char*)d_ws + OFF_BAR, 0, 16384, stream);
  void* args[] = {&p};
  hipError_t err = hipLaunchCooperativeKernel((void*)trunk_megakernel, dim3(grid_blocks), dim3(NTHREADS), args, 0, stream);
  if (err != hipSuccess) fprintf(stderr, "cooperative launch failed: %s (grid %d)\n", hipGetErrorString(err), grid_blocks);
}
```
